# Optimizing an MI355X kernel written in HIP

```python
import jax, jax.numpy as jnp
from jax import lax
import numpy as np

D_MODEL = 1024
BATCH = 2
SEQ = 8192
DEPTH = 1

N_META = 16
D_MIX = D_MODEL
GLA_WIDTH = D_MIX // 2
GLA_HEADS = 4
GLA_DV = GLA_WIDTH // GLA_HEADS
GLA_DK = GLA_DV // 2
GLA_KEY_WIDTH = GLA_HEADS * GLA_DK
GLA_GATE_RANK = 16
GLA_TAU = 16.0
GLA_CHUNK = 64
SWA_WIDTH = D_MIX - GLA_WIDTH
SWA_HEAD_DIM = 64
SWA_Q_HEADS = SWA_WIDTH // SWA_HEAD_DIM
SWA_KV_HEADS = 2
SWA_GROUP = SWA_Q_HEADS // SWA_KV_HEADS
SWA_KV_WIDTH = SWA_KV_HEADS * SWA_HEAD_DIM
WINDOW = 128
SWA_BLOCK = 128
ROPE_THETA = 10000.0
D_FF = 256 * ((8 * D_MODEL // 3 + 255) // 256)
NORM_EPS = 1e-6
NEG_INF = -1e30

IN_SPLITS = (GLA_KEY_WIDTH, GLA_KEY_WIDTH, GLA_WIDTH, GLA_WIDTH, GLA_GATE_RANK,
             SWA_WIDTH, SWA_KV_WIDTH, SWA_KV_WIDTH)
D_IN = sum(IN_SPLITS)

kernel_name = "hybrid_gla_swa_macaron_layer"


def rms_norm(x, w):
    xf = x.astype(jnp.float32)
    y = xf * lax.rsqrt(jnp.mean(xf * xf, axis=-1, keepdims=True) + NORM_EPS)
    return (y * w.astype(jnp.float32)).astype(x.dtype)


def swiglu(x, w_gate, w_up, w_down):
    return (jax.nn.silu(x @ w_gate) * (x @ w_up)) @ w_down


def rope(x, pos):
    hd = x.shape[-1]
    inv_freq = 1.0 / (ROPE_THETA ** (jnp.arange(0, hd, 2, dtype=jnp.float32) / hd))
    ang = pos.astype(jnp.float32)[:, None] * inv_freq[None, :]
    ang = jnp.concatenate([ang, ang], axis=-1)[:, None, :]
    xf = x.astype(jnp.float32)
    x1, x2 = jnp.split(xf, 2, axis=-1)
    rot = jnp.concatenate([-x2, x1], axis=-1)
    return (xf * jnp.cos(ang) + rot * jnp.sin(ang)).astype(x.dtype)


def gla_chunked(q, k, v, log_a):
    B, L, H, dk = q.shape
    dv = v.shape[-1]
    C = GLA_CHUNK
    pad = (-L) % C
    n = (L + pad) // C

    def to_chunks(t):
        t = jnp.pad(t, ((0, 0), (pad, 0), (0, 0), (0, 0)))
        return t.reshape(B, n, C, H, t.shape[-1]).transpose(1, 0, 3, 2, 4).astype(jnp.float32)

    qc = to_chunks(q) * (dk ** -0.5)
    kc = to_chunks(k)
    vc = to_chunks(v)
    bc = jnp.cumsum(to_chunks(log_a), axis=3)
    causal = jnp.tril(jnp.ones((C, C), dtype=bool))[None, None, :, :, None]

    def step(S, inp):
        qi, ki, vi, bi = inp
        diff = bi[:, :, :, None, :] - bi[:, :, None, :, :]
        decay = jnp.exp(jnp.where(causal, diff, -jnp.inf))
        attn = jnp.einsum('bhid,bhjd,bhijd->bhij', qi, ki, decay)
        o = jnp.einsum('bhij,bhjv->bhiv', attn, vi) + \
            jnp.einsum('bhid,bhdv->bhiv', qi * jnp.exp(bi), S)
        b_last = bi[:, :, -1:, :]
        S = jnp.exp(b_last[:, :, 0, :])[..., None] * S + \
            jnp.einsum('bhjd,bhjv->bhdv', ki * jnp.exp(b_last - bi), vi)
        return S, o

    S0 = jnp.zeros((B, H, dk, dv), jnp.float32)
    _, o = lax.scan(step, S0, (qc, kc, vc, bc))
    o = o.transpose(1, 0, 3, 2, 4).reshape(B, n * C, H, dv)[:, pad:]
    return o.astype(v.dtype)


def swa_with_sinks(q, k, v, sinks):
    B, L, HQ, hd = q.shape
    T = SWA_BLOCK
    KV, G = SWA_KV_HEADS, SWA_GROUP
    pad = (-L) % T
    Lp = L + pad
    nb = Lp // T
    qb = jnp.pad(q, ((0, 0), (pad, 0), (0, 0), (0, 0))).reshape(B, nb, T, KV, G, hd)
    kp = jnp.pad(k, ((0, 0), (pad + T, 0), (0, 0), (0, 0))).reshape(B, nb + 1, T, KV, hd)
    vp = jnp.pad(v, ((0, 0), (pad + T, 0), (0, 0), (0, 0))).reshape(B, nb + 1, T, KV, hd)
    k_band = jnp.concatenate([kp[:, :-1], kp[:, 1:]], axis=2)
    v_band = jnp.concatenate([vp[:, :-1], vp[:, 1:]], axis=2)
    k_meta = k[:, :N_META]
    v_meta = v[:, :N_META]

    qpos = (jnp.arange(Lp) - pad).reshape(nb, T)
    kpos_all = (jnp.arange(Lp + T) - pad - T).reshape(nb + 1, T)
    kpos = jnp.concatenate([kpos_all[:-1], kpos_all[1:]], axis=1)
    dq = qpos[:, :, None]
    dk_ = kpos[:, None, :]
    band_mask = (dk_ >= N_META) & (dk_ <= dq) & (dq - dk_ < WINDOW)
    meta_mask = jnp.arange(N_META)[None, None, :] <= dq
    mask = jnp.concatenate([band_mask, meta_mask], axis=-1)

    scale = hd ** -0.5
    s_band = jnp.einsum('bntkgd,bnskd->bnkgts', qb, k_band).astype(jnp.float32)
    s_meta = jnp.einsum('bntkgd,bmkd->bnkgtm', qb, k_meta).astype(jnp.float32)
    s = jnp.concatenate([s_band, s_meta], axis=-1) * scale
    s = jnp.where(mask[None, :, None, None], s, NEG_INF)
    sink = sinks.astype(jnp.float32).reshape(KV, G)[None, None, :, :, None, None]
    m = jnp.maximum(jnp.max(s, axis=-1, keepdims=True), sink)
    p = jnp.exp(s - m)
    p = p / (jnp.sum(p, axis=-1, keepdims=True) + jnp.exp(sink - m))
    p = p.astype(v.dtype)
    o = jnp.einsum('bnkgts,bnskd->bntkgd', p[..., :2 * T], v_band) + \
        jnp.einsum('bnkgtm,bmkd->bntkgd', p[..., 2 * T:], v_meta)
    return o.reshape(B, Lp, HQ, hd)[:, pad:]


def hybrid_mixer(h, w_in, gla_w_a2, gla_b_a, gla_out_norm, swa_sinks, swa_out_norm, w_out):
    B, L, _ = h.shape
    pos = jnp.arange(L, dtype=jnp.int32)
    proj = h @ w_in
    offsets = [int(o) for o in np.cumsum(IN_SPLITS)[:-1]]
    gq, gk, gv, gg, ga, sq, sk, sv = jnp.split(proj, offsets, axis=-1)

    log_a = jax.nn.log_sigmoid((ga @ gla_w_a2 + gla_b_a).astype(jnp.float32)) / GLA_TAU
    o_gla = gla_chunked(gq.reshape(B, L, GLA_HEADS, GLA_DK),
                        gk.reshape(B, L, GLA_HEADS, GLA_DK),
                        gv.reshape(B, L, GLA_HEADS, GLA_DV),
                        log_a.reshape(B, L, GLA_HEADS, GLA_DK))
    o_gla = rms_norm(o_gla, gla_out_norm) * jax.nn.silu(gg.reshape(B, L, GLA_HEADS, GLA_DV))
    o_gla = o_gla.reshape(B, L, GLA_WIDTH)

    q = rope(sq.reshape(B, L, SWA_Q_HEADS, SWA_HEAD_DIM), pos)
    k = rope(sk.reshape(B, L, SWA_KV_HEADS, SWA_HEAD_DIM), pos)
    v = sv.reshape(B, L, SWA_KV_HEADS, SWA_HEAD_DIM)
    o_swa = swa_with_sinks(q, k, v, swa_sinks).reshape(B, L, SWA_WIDTH)
    o_swa = rms_norm(o_swa, swa_out_norm)

    return jnp.concatenate([o_gla, o_swa], axis=-1) @ w_out


def setup_inputs(seed: int = 0) -> dict:
    key = jax.random.key(seed)
    ks = jax.random.split(key, 24)
    f32 = jnp.float32
    nrm = lambda k, shape, s: jax.random.normal(k, shape, f32) * s
    gain = lambda k, shape: 1.0 + 0.05 * jax.random.normal(k, shape, f32)
    Dp = DEPTH
    return {
        "x": jax.random.normal(ks[0], (BATCH, SEQ, D_MODEL), f32),
        "meta_tokens": nrm(ks[1], (N_META, D_MODEL), 1.0),
        "ffn1_pre_norm": gain(ks[2], (Dp, D_MODEL)),
        "ffn1_w_gate": nrm(ks[3], (Dp, D_MODEL, D_FF), D_MODEL ** -0.5),
        "ffn1_w_up": nrm(ks[4], (Dp, D_MODEL, D_FF), D_MODEL ** -0.5),
        "ffn1_w_down": nrm(ks[5], (Dp, D_FF, D_MODEL), D_FF ** -0.5),
        "ffn1_post_norm": gain(ks[6], (Dp, D_MODEL)),
        "mix_pre_norm": gain(ks[7], (Dp, D_MODEL)),
        "w_in": nrm(ks[8], (Dp, D_MODEL, D_IN), D_MODEL ** -0.5),
        "gla_w_a2": nrm(ks[9], (Dp, GLA_GATE_RANK, GLA_KEY_WIDTH), GLA_GATE_RANK ** -0.5),
        "gla_b_a": nrm(ks[10], (Dp, GLA_KEY_WIDTH), 0.1),
        "gla_out_norm": gain(ks[11], (Dp, GLA_DV)),
        "swa_sinks": nrm(ks[12], (Dp, SWA_Q_HEADS), 0.5),
        "swa_out_norm": gain(ks[13], (Dp, SWA_WIDTH)),
        "w_out": nrm(ks[14], (Dp, D_MIX, D_MODEL), D_MIX ** -0.5),
        "mix_post_norm": gain(ks[15], (Dp, D_MODEL)),
        "ffn2_pre_norm": gain(ks[16], (Dp, D_MODEL)),
        "ffn2_w_gate": nrm(ks[17], (Dp, D_MODEL, D_FF), D_MODEL ** -0.5),
        "ffn2_w_up": nrm(ks[18], (Dp, D_MODEL, D_FF), D_MODEL ** -0.5),
        "ffn2_w_down": nrm(ks[19], (Dp, D_FF, D_MODEL), D_FF ** -0.5),
        "ffn2_post_norm": gain(ks[20], (Dp, D_MODEL)),
    }


def reference(x, meta_tokens, ffn1_pre_norm, ffn1_w_gate, ffn1_w_up, ffn1_w_down, ffn1_post_norm,
              mix_pre_norm, w_in, gla_w_a2, gla_b_a, gla_out_norm, swa_sinks, swa_out_norm, w_out,
              mix_post_norm, ffn2_pre_norm, ffn2_w_gate, ffn2_w_up, ffn2_w_down, ffn2_post_norm):
    B = x.shape[0]
    meta = jnp.broadcast_to(meta_tokens.astype(x.dtype)[None], (B, N_META, x.shape[-1]))
    h = jnp.concatenate([meta, x], axis=1)
    for l in range(DEPTH):
        f = swiglu(rms_norm(h, ffn1_pre_norm[l]), ffn1_w_gate[l], ffn1_w_up[l], ffn1_w_down[l])
        h = h + 0.5 * rms_norm(f, ffn1_post_norm[l])
        m = hybrid_mixer(rms_norm(h, mix_pre_norm[l]), w_in[l], gla_w_a2[l], gla_b_a[l],
                         gla_out_norm[l], swa_sinks[l], swa_out_norm[l], w_out[l])
        h = h + rms_norm(m, mix_post_norm[l])
        f = swiglu(rms_norm(h, ffn2_pre_norm[l]), ffn2_w_gate[l], ffn2_w_up[l], ffn2_w_down[l])
        h = h + 0.5 * rms_norm(f, ffn2_post_norm[l])
    return h[:, N_META:]
```

```cpp
#include <hip/hip_runtime.h>
#include <hip/hip_cooperative_groups.h>
#include <cstdio>
#include <cstdint>
#include <cmath>
namespace pg8 {
#define PG8_LAS __attribute__((address_space(3)))
typedef unsigned short bf16_t;
typedef short bf16x8 __attribute__((ext_vector_type(8)));
typedef float f32x4 __attribute__((ext_vector_type(4)));
typedef unsigned u32x4 __attribute__((ext_vector_type(4)));
constexpr int BM = 256, BK = 64, HALF = 128, HTB = HALF * BK * 2  , STAGE_BYTES = 8 * HTB, NXCD = 8, WGM = 8;

__host__ __device__ __forceinline__ int lds_byte(int r, int c) { const int st = (r >> 4) * 2 + (c >> 5), rr = r & 15, cc = c & 31, ob = rr * 64 + cc * 2; return st * 1024 + (ob ^ (((ob >> 9) & 1) << 5)); }
__host__ __device__ __forceinline__ void stage_rc(int b, int& R, int& C) { const int st = b / 1024, sb = b % 1024, swz = sb ^ (((sb >> 9) & 1) << 5); R = (st >> 1) * 16 + swz / 64; C = (st & 1) * 32 + (swz % 64) / 2; }
__host__ __device__ __forceinline__ int perm32(int rho) { const int n = rho >> 4, i = rho & 15; return 8 * (i >> 2) + 4 * n + (i & 3); }

struct Unit { int pm, pn; };
struct Gemm { const bf16_t* A; const bf16_t* Bt; int M, N, K; };

struct StaticOrder {
    int nM, nN, nwg, G, c;
    __host__ __device__ void init(int M, int N, int G_, int c_) { nM = M / BM; nN = N / BM; nwg = nM * nN; G = G_; c = c_; }
    __host__ __device__ bool next(int i, Unit& u) const {
        const long L = (long)i * G + c; if (L >= nwg) return false;
        int wgid = (int)L; { const int q = nwg / NXCD, r = nwg % NXCD, xcd = wgid % NXCD, off = wgid / NXCD; wgid = (xcd < r ? xcd * (q + 1) : r * (q + 1) + (xcd - r) * q) + off; }
        const int nig = WGM * nN, gid = wgid / nig, fm = gid * WGM, gsz = (nM - fm) < WGM ? (nM - fm) : WGM;
        u.pm = fm + ((wgid % nig) % gsz); u.pn = (wgid % nig) / gsz; return true;
    }
    __device__ __forceinline__ void a_ready(const Unit&) const {}
    __device__ __forceinline__ void done(const Unit&) const {}
};

__device__ __forceinline__ unsigned cvt_pk_bf16(float lo, float hi) { unsigned r; asm volatile("v_cvt_pk_bf16_f32 %0, %1, %2" : "=v"(r) : "v"(lo), "v"(hi)); return r; }
__device__ __forceinline__ float silu_f(float x) { return x * __builtin_amdgcn_rcpf(1.0f + __builtin_amdgcn_exp2f(-1.4426950408889634f * x)); }
struct EpiPlain {
    static constexpr bool PERM = true, AFTER_DRAIN = false;
    bf16_t* O; int ldc;
    __device__ __forceinline__ void operator()(const f32x4 (&acc)[2][2][4][2], const Unit& u, int wr, int wc, int fr, int fq) const {
        const int row0 = u.pm * BM + wr * 64 + fr, col0 = u.pn * BM + wc * 32 + 8 * fq;
#pragma unroll
        for (int ai = 0; ai < 2; ++ai)
#pragma unroll
            for (int m = 0; m < 4; ++m) { bf16_t* rowp = O + (size_t)(row0 + ai * HALF + m * 16) * ldc + col0;
#pragma unroll
                for (int bj = 0; bj < 2; ++bj) { const f32x4 v0 = acc[ai][bj][m][0], v1 = acc[ai][bj][m][1];
                    u32x4 w; w.x = cvt_pk_bf16(v0[0], v0[1]); w.y = cvt_pk_bf16(v0[2], v0[3]); w.z = cvt_pk_bf16(v1[0], v1[1]); w.w = cvt_pk_bf16(v1[2], v1[3]);
                    *(u32x4*)(rowp + bj * HALF) = w; } }
    }
};
struct EpiSwiglu {
    static constexpr bool PERM = true, AFTER_DRAIN = false;
    bf16_t* O; int ldc;
    __device__ __forceinline__ void operator()(const f32x4 (&acc)[2][2][4][2], const Unit& u, int wr, int wc, int fr, int fq) const {
        const int row0 = u.pm * BM + wr * 64 + fr, col0 = u.pn * HALF + wc * 32 + 8 * fq;
#pragma unroll
        for (int ai = 0; ai < 2; ++ai)
#pragma unroll
            for (int m = 0; m < 4; ++m) { bf16_t* rowp = O + (size_t)(row0 + ai * HALF + m * 16) * ldc + col0;
                const f32x4 g0 = acc[ai][0][m][0], g1 = acc[ai][0][m][1], u0 = acc[ai][1][m][0], u1 = acc[ai][1][m][1];
                u32x4 w; w.x = cvt_pk_bf16(silu_f(g0[0]) * u0[0], silu_f(g0[1]) * u0[1]); w.y = cvt_pk_bf16(silu_f(g0[2]) * u0[2], silu_f(g0[3]) * u0[3]);
                w.z = cvt_pk_bf16(silu_f(g1[0]) * u1[0], silu_f(g1[1]) * u1[1]); w.w = cvt_pk_bf16(silu_f(g1[2]) * u1[2], silu_f(g1[3]) * u1[3]);
                *(u32x4*)rowp = w; }
    }
};
struct EpiProj {
    static constexpr bool PERM = true, AFTER_DRAIN = false;
    bf16_t *GQ, *GK, *GV, *GG, *SQ, *SK, *SV; float* GA; const float* rope;
    __device__ __forceinline__ void operator()(const f32x4 (&acc)[2][2][4][2], const Unit& u, int wr, int wc, int fr, int fq) const {
        const int pn = u.pn, row0 = u.pm * BM + wr * 64 + fr;
        if (pn < 6) {
            bf16_t* base; int ld, coff;
            if (pn == 0) { base = GQ; ld = 256; coff = 0; } else if (pn == 1) { base = GK; ld = 256; coff = 0; }
            else if (pn < 4) { base = GV; ld = 512; coff = (pn - 2) * 256; } else { base = GG; ld = 512; coff = (pn - 4) * 256; }
            const bool act = pn >= 4;
#pragma unroll
            for (int ai = 0; ai < 2; ++ai)
#pragma unroll
                for (int m = 0; m < 4; ++m) { bf16_t* rowp = base + (size_t)(row0 + ai * HALF + m * 16) * ld + coff + wc * 32 + 8 * fq;
#pragma unroll
                    for (int bj = 0; bj < 2; ++bj) { f32x4 v0 = acc[ai][bj][m][0], v1 = acc[ai][bj][m][1];
                        if (act) { v0 = (f32x4){silu_f(v0[0]), silu_f(v0[1]), silu_f(v0[2]), silu_f(v0[3])}; v1 = (f32x4){silu_f(v1[0]), silu_f(v1[1]), silu_f(v1[2]), silu_f(v1[3])}; }
                        u32x4 w; w.x = cvt_pk_bf16(v0[0], v0[1]); w.y = cvt_pk_bf16(v0[2], v0[3]); w.z = cvt_pk_bf16(v1[0], v1[1]); w.w = cvt_pk_bf16(v1[2], v1[3]);
                        *(u32x4*)(rowp + bj * HALF) = w; } }
        } else if (pn < 9) {
            bf16_t* base; int ld, coff; float sc = 1.f; bool do_rope = true;
            if (pn < 8) { base = SQ; ld = 512; coff = (4 * (pn - 6) + wc) * 64; sc = 0.125f; }
            else if (wc < 2) { base = SK; ld = 128; coff = wc * 64; }
            else { base = SV; ld = 128; coff = (wc - 2) * 64; do_rope = false; }
#pragma unroll
            for (int ai = 0; ai < 2; ++ai)
#pragma unroll
                for (int m = 0; m < 4; ++m) { const int row = row0 + ai * HALF + m * 16; const int pos = row < 16384 ? (row & 8191) + 16 : row - 16384;
                    const float* rp = rope + (size_t)pos * 64 + 8 * fq;
                    f32x4 o1[2], o2[2];
#pragma unroll
                    for (int n = 0; n < 2; ++n) { const f32x4 x1 = acc[ai][0][m][n], x2 = acc[ai][1][m][n];
                        if (do_rope) { const f32x4 c = *(const f32x4*)(rp + 4 * n), s = *(const f32x4*)(rp + 32 + 4 * n); o1[n] = (x1 * c - x2 * s) * sc; o2[n] = (x2 * c + x1 * s) * sc; }
                        else { o1[n] = x1; o2[n] = x2; } }
                    bf16_t* rowp = base + (size_t)row * ld + coff + 8 * fq;
                    u32x4 w; w.x = cvt_pk_bf16(o1[0][0], o1[0][1]); w.y = cvt_pk_bf16(o1[0][2], o1[0][3]); w.z = cvt_pk_bf16(o1[1][0], o1[1][1]); w.w = cvt_pk_bf16(o1[1][2], o1[1][3]);
                    *(u32x4*)rowp = w;
                    w.x = cvt_pk_bf16(o2[0][0], o2[0][1]); w.y = cvt_pk_bf16(o2[0][2], o2[0][3]); w.z = cvt_pk_bf16(o2[1][0], o2[1][1]); w.w = cvt_pk_bf16(o2[1][2], o2[1][3]);
                    *(u32x4*)(rowp + 32) = w; }
        } else {
            if (wc == 0 && fq < 2) {
#pragma unroll
                for (int ai = 0; ai < 2; ++ai)
#pragma unroll
                    for (int m = 0; m < 4; ++m) { float* rowp = GA + (size_t)(row0 + ai * HALF + m * 16) * 16 + 8 * fq;
                        *(f32x4*)rowp = acc[ai][0][m][0]; *(f32x4*)(rowp + 4) = acc[ai][0][m][1]; }
            }
        }
    }
};

template <class Epi, class Sched, bool ALIGN_EPI = false, bool SP2 = false>
__device__ __forceinline__ void gemm_phase(PG8_LAS unsigned char* lds, const Gemm g, const Sched& S, const Epi& E) {
    const int tid = threadIdx.x, wid = __builtin_amdgcn_readfirstlane(tid >> 6), lane = tid & 63, wr = wid >> 2, wc = wid & 3, fr = lane & 15, fq = lane >> 4;
    const int K = g.K, nt = K / BK;
    unsigned voffA[2], voffB[2];
#pragma unroll
    for (int i = 0; i < 2; ++i) { int R, C; stage_rc(tid * 16 + i * 8192, R, C); const int Rb = Epi::PERM ? ((R & ~31) + perm32(R & 31)) : R;
        voffA[i] = (unsigned)(R * K + C) * 2u; voffB[i] = (unsigned)(Rb * K + C) * 2u; }
    const size_t kstep = (size_t)(BK * 2);
    const size_t hstep = (size_t)HALF * K * 2;
    const size_t tstep = 2 * hstep;
    const unsigned ldsw = (unsigned)wid * 1024u;
    const int aoff = lds_byte(wr * 64 + fr, fq * 8), boff = lds_byte(wc * 32 + fr, fq * 8);
#define PG8_SA(b, h) (((b) * 2 + (h)) * HTB)
#define PG8_SB(b, h) ((4 + (b) * 2 + (h)) * HTB)
#define PG8_STAGE(bufoff, gbase, voff) do { _Pragma("unroll") for (int _i = 0; _i < 2; ++_i) \
        __builtin_amdgcn_global_load_lds((const unsigned*)((const char*)(gbase) + (voff)[_i]), (PG8_LAS unsigned*)(lds + (bufoff) + ldsw + _i * 8192), 16, 0, 0); } while (0)
#define PG8_LDA(dst, b, h) do { _Pragma("unroll") for (int m = 0; m < 4; ++m) _Pragma("unroll") for (int k = 0; k < 2; ++k) dst[m][k] = *(const PG8_LAS bf16x8*)(lds + PG8_SA(b, h) + aoff + m * 2048 + k * 1024); } while (0)
#define PG8_LDB(dst, b, h) do { _Pragma("unroll") for (int n = 0; n < 2; ++n) _Pragma("unroll") for (int k = 0; k < 2; ++k) dst[n][k] = *(const PG8_LAS bf16x8*)(lds + PG8_SB(b, h) + boff + n * 2048 + k * 1024); } while (0)
#define PG8_MMA(ai, bj, At, Bt) do { __builtin_amdgcn_s_setprio(1); _Pragma("unroll") for (int m = 0; m < 4; ++m) _Pragma("unroll") for (int n = 0; n < 2; ++n) _Pragma("unroll") for (int k = 0; k < 2; ++k) \
        acc[ai][bj][m][n] = __builtin_amdgcn_mfma_f32_16x16x32_bf16(Bt[n][k], At[m][k], acc[ai][bj][m][n], 0, 0, 0); __builtin_amdgcn_s_setprio(0); } while (0)
#define PG8_WAIT_V(n) asm volatile("s_waitcnt vmcnt(" #n ")" ::: "memory")
#define PG8_WAIT_L(n) asm volatile("s_waitcnt lgkmcnt(" #n ")" ::: "memory")
#define PG8_BAR __builtin_amdgcn_s_barrier()
#define PG8_SCHED __builtin_amdgcn_sched_barrier(0)
    Unit cur, nxt; int ui = 0;
    if (!S.next(0, cur)) return;
    f32x4 acc[2][2][4][2];
#pragma unroll
    for (int a = 0; a < 2; ++a)
#pragma unroll
        for (int b = 0; b < 2; ++b)
#pragma unroll
            for (int m = 0; m < 4; ++m)
#pragma unroll
                for (int n = 0; n < 2; ++n) acc[a][b][m][n] = (f32x4){0.f, 0.f, 0.f, 0.f};
    bf16x8 At[4][2], B0[2][2], B1[2][2];
    const char* cA = (const char*)g.A + (size_t)cur.pm * tstep; const char* cB = (const char*)g.Bt + (size_t)cur.pn * tstep;
    S.a_ready(cur);
    if constexpr (SP2) {
        PG8_STAGE(PG8_SB(0, 0), cB, voffB); PG8_STAGE(PG8_SB(0, 1), cB + hstep, voffB); PG8_STAGE(PG8_SA(0, 0), cA, voffA); PG8_STAGE(PG8_SA(0, 1), cA + hstep, voffA);
        if (wr == 1) PG8_BAR;
        PG8_WAIT_V(2); PG8_BAR;
        PG8_STAGE(PG8_SB(1, 0), cB + kstep, voffB); PG8_STAGE(PG8_SA(1, 0), cA + kstep, voffA); PG8_STAGE(PG8_SB(1, 1), cB + hstep + kstep, voffB);
        PG8_WAIT_V(6); PG8_BAR;
    } else {
        PG8_STAGE(PG8_SB(0, 0), cB, voffB); PG8_STAGE(PG8_SA(0, 0), cA, voffA); PG8_STAGE(PG8_SB(0, 1), cB + hstep, voffB); PG8_STAGE(PG8_SA(0, 1), cA + hstep, voffA);
        if (wr == 1) PG8_BAR;
        PG8_WAIT_V(4); PG8_BAR;
        PG8_STAGE(PG8_SB(1, 0), cB + kstep, voffB); PG8_STAGE(PG8_SA(1, 0), cA + kstep, voffA); PG8_STAGE(PG8_SB(1, 1), cB + hstep + kstep, voffB);
        PG8_WAIT_V(6); PG8_BAR;
    }
    for (;;) {
        const bool has_next = S.next(ui + 1, nxt);
        const char* nA = has_next ? (const char*)g.A + (size_t)nxt.pm * tstep : cA; const char* nB = has_next ? (const char*)g.Bt + (size_t)nxt.pn * tstep : cB;
        for (int t = 0; t < nt; t += 2) {
            const bool last = (t == nt - 2);
            const char* a1 = cA + (size_t)(t + 1) * kstep;
            const char* a2 = last ? nA : cA + (size_t)(t + 2) * kstep; const char* b2 = last ? nB : cB + (size_t)(t + 2) * kstep;
            const char* a3 = a2 + kstep; const char* b3 = b2 + kstep;
            if (last && has_next) S.a_ready(nxt);
            if constexpr (SP2) {
            PG8_LDB(B0, 0, 0); PG8_LDB(B1, 0, 1); PG8_SCHED; PG8_LDA(At, 0, 0); PG8_STAGE(PG8_SA(1, 1), a1 + hstep, voffA);
            PG8_WAIT_V(8); PG8_WAIT_L(0); PG8_BAR; PG8_MMA(0, 0, At, B0); PG8_MMA(0, 1, At, B1); PG8_BAR; PG8_SCHED;
            PG8_LDA(At, 0, 1); PG8_STAGE(PG8_SB(0, 0), b2, voffB); PG8_STAGE(PG8_SB(0, 1), b2 + hstep, voffB); PG8_STAGE(PG8_SA(0, 0), a2, voffA);
            PG8_WAIT_V(8); PG8_WAIT_L(0); PG8_BAR; PG8_MMA(1, 0, At, B0); PG8_MMA(1, 1, At, B1); PG8_BAR; PG8_SCHED;
            PG8_LDB(B0, 1, 0); PG8_LDB(B1, 1, 1); PG8_SCHED; PG8_LDA(At, 1, 0); PG8_STAGE(PG8_SA(0, 1), a2 + hstep, voffA);
            PG8_WAIT_V(8); PG8_WAIT_L(0); PG8_BAR; PG8_MMA(0, 0, At, B0); PG8_MMA(0, 1, At, B1); PG8_BAR; PG8_SCHED;
            PG8_LDA(At, 1, 1); PG8_STAGE(PG8_SB(1, 0), b3, voffB); PG8_STAGE(PG8_SB(1, 1), b3 + hstep, voffB); PG8_STAGE(PG8_SA(1, 0), a3, voffA);
            PG8_WAIT_V(8); PG8_WAIT_L(0); PG8_BAR; PG8_MMA(1, 0, At, B0); PG8_MMA(1, 1, At, B1); PG8_BAR; PG8_SCHED;
            } else {
            PG8_LDB(B0, 0, 0); PG8_SCHED; PG8_LDA(At, 0, 0); PG8_STAGE(PG8_SA(1, 1), a1 + hstep, voffA);
            PG8_WAIT_L(8); PG8_BAR; PG8_WAIT_L(0); PG8_MMA(0, 0, At, B0); PG8_BAR; PG8_SCHED;
            PG8_LDB(B1, 0, 1); PG8_STAGE(PG8_SB(0, 0), b2, voffB);
            PG8_BAR; PG8_WAIT_L(0); PG8_MMA(0, 1, At, B1); PG8_BAR;
            PG8_LDA(At, 0, 1); PG8_STAGE(PG8_SA(0, 0), a2, voffA);
            PG8_BAR; PG8_WAIT_L(0); PG8_MMA(1, 0, At, B0); PG8_BAR; PG8_SCHED;
            PG8_STAGE(PG8_SB(0, 1), b2 + hstep, voffB);
            PG8_WAIT_V(6); PG8_BAR; PG8_MMA(1, 1, At, B1); PG8_BAR;
            PG8_LDB(B0, 1, 0); PG8_SCHED; PG8_LDA(At, 1, 0); PG8_STAGE(PG8_SA(0, 1), a2 + hstep, voffA);
            PG8_WAIT_L(8); PG8_BAR; PG8_WAIT_L(0); PG8_MMA(0, 0, At, B0); PG8_BAR; PG8_SCHED;
            PG8_LDB(B1, 1, 1); PG8_STAGE(PG8_SB(1, 0), b3, voffB);
            PG8_BAR; PG8_WAIT_L(0); PG8_MMA(0, 1, At, B1); PG8_BAR;
            PG8_LDA(At, 1, 1); PG8_STAGE(PG8_SA(1, 0), a3, voffA);
            PG8_BAR; PG8_WAIT_L(0); PG8_MMA(1, 0, At, B0); PG8_BAR; PG8_SCHED;
            PG8_STAGE(PG8_SB(1, 1), b3 + hstep, voffB);
            PG8_WAIT_V(6); PG8_BAR; PG8_MMA(1, 1, At, B1); PG8_BAR;
            }
        }
        if constexpr (ALIGN_EPI) { if (wr == 0) PG8_BAR; }
        if constexpr (!Epi::AFTER_DRAIN) { E(acc, cur, wr, wc, fr, fq); S.done(cur); }
        if (!has_next) break;
#pragma unroll
        for (int a = 0; a < 2; ++a)
#pragma unroll
            for (int b = 0; b < 2; ++b)
#pragma unroll
                for (int m = 0; m < 4; ++m)
#pragma unroll
                    for (int n = 0; n < 2; ++n) acc[a][b][m][n] = (f32x4){0.f, 0.f, 0.f, 0.f};
        cur = nxt; cA = nA; cB = nB; ++ui;
        if constexpr (ALIGN_EPI) { if (wr == 1) PG8_BAR; }
    }
    PG8_WAIT_V(0);
    if constexpr (!ALIGN_EPI) { if (wr == 0) PG8_BAR; }
    PG8_BAR;
    if constexpr (Epi::AFTER_DRAIN) { E.fused(acc, cur, wr, wc, fr, fq, lds, wid, lane); S.done(cur); }
#undef PG8_SA
#undef PG8_SB
#undef PG8_STAGE
#undef PG8_LDA
#undef PG8_LDB
#undef PG8_MMA
#undef PG8_WAIT_V
#undef PG8_WAIT_L
#undef PG8_BAR
#undef PG8_SCHED
}
}

namespace cg = cooperative_groups;
typedef unsigned short bf16;
typedef float f32x4 __attribute__((ext_vector_type(4)));
typedef short bf16x8 __attribute__((ext_vector_type(8)));
typedef short s16x4 __attribute__((ext_vector_type(4)));
typedef unsigned u32x2 __attribute__((ext_vector_type(2)));
typedef unsigned u32x4 __attribute__((ext_vector_type(4)));

constexpr int D = 1024, FF = 2816, SEQ = 8192, NX = 16384, NMETA = 16, NR = NX + NMETA, NRP = 16640;
constexpr int NGU = 2 * FF, NPROJ = 2560;
constexpr float EPS = 1e-6f;
constexpr int NTHREADS = 512, NWAVES = 8;
constexpr int LDS_BYTES = 147456;

constexpr size_t SZ_WGU = (size_t)NGU * D * 2, SZ_WD = (size_t)D * FF * 2, SZ_WIN = (size_t)NPROJ * D * 2, SZ_WOUT = (size_t)D * D * 2;
constexpr size_t WS_WGU1 = 0, WS_WD1 = WS_WGU1 + SZ_WGU, WS_WIN = WS_WD1 + SZ_WD, WS_WOUT = WS_WIN + SZ_WIN, WS_WGU2 = WS_WOUT + SZ_WOUT, WS_WD2 = WS_WGU2 + SZ_WGU;
constexpr size_t WS_ROPE = WS_WD2 + SZ_WD, SZ_ROPE = (size_t)(SEQ + NMETA) * 64 * 4;
constexpr size_t WS_DL = WS_ROPE + SZ_ROPE, SZ_DL = (size_t)8 * 128 * 64 * 4;
constexpr size_t WS_A = WS_DL + SZ_DL, SZ_A = (size_t)NRP * D * 2;
constexpr size_t WS_F = WS_A + SZ_A, SZ_F = SZ_A;
constexpr size_t WS_ST = WS_F + SZ_F, SZ_ST = (size_t)8 * 128 * 8192 * 2;
constexpr size_t WS_ACT = WS_ST + SZ_ST, SZ_ACT = (size_t)NRP * FF * 2;
constexpr size_t WS_END = WS_ACT + SZ_ACT;
static_assert(WS_END <= (size_t)256 * 1024 * 1024, "ws map");
static_assert((size_t)8 * 128 * 8192 * 4 <= SZ_F, "UT fits in F");
constexpr size_t PO_GQ = 0, PO_GK = PO_GQ + (size_t)NRP * 256 * 2, PO_GV = PO_GK + (size_t)NRP * 256 * 2, PO_GG = PO_GV + (size_t)NRP * 512 * 2,
                 PO_SQ = PO_GG + (size_t)NRP * 512 * 2, PO_SK = PO_SQ + (size_t)NRP * 512 * 2, PO_SV = PO_SK + (size_t)NRP * 128 * 2, PO_GA = PO_SV + (size_t)NRP * 128 * 2,
                 PO_END = PO_GA + (size_t)NRP * 16 * 4;
static_assert(PO_END <= SZ_ACT, "projection outputs fit in ACT");

struct Params {
    const float *x, *meta, *n1pre, *wg1, *wu1, *wd1, *n1post, *nmixpre, *win, *wa2, *ba, *glanorm, *sinks, *swanorm, *wout, *nmixpost, *n2pre, *wg2, *wu2, *wd2, *n2post;
    float* out; unsigned char* ws;
};

__device__ __forceinline__ unsigned f2bf(float f) { unsigned u = __builtin_bit_cast(unsigned, f); return (u + 0x7fffu + ((u >> 16) & 1u)) >> 16; }
__device__ __forceinline__ unsigned pk2(float lo, float hi) { return f2bf(lo) | (f2bf(hi) << 16); }
__device__ __forceinline__ float bf2f(unsigned short b) { return __builtin_bit_cast(float, (unsigned)b << 16); }
__device__ __forceinline__ float wave_sum(float v) {
#pragma unroll
    for (int o = 1; o < 64; o <<= 1) v += __shfl_xor(v, o);
    return v;
}
__device__ __forceinline__ f32x4 mma16(bf16x8 first, bf16x8 second, f32x4 c) { return __builtin_amdgcn_mfma_f32_16x16x32_bf16(first, second, c, 0, 0, 0); }

__device__ __forceinline__ void transpose_item(const float* W, int Nsrc, int K, int srccol, int nvalid, bf16* WT, int destrow0, int kb, float* scr, int lane) {
    const int k0 = 64 * kb, c = lane & 31;
#pragma unroll 8
    for (int i = 0; i < 32; ++i) { const int kk = 2 * i + (lane >> 5); scr[kk * 33 + c] = (c < nvalid) ? W[(size_t)(k0 + kk) * Nsrc + srccol + c] : 0.f; }
    asm volatile("s_waitcnt lgkmcnt(0)" ::: "memory");
    const int c8 = lane & 7;
#pragma unroll
    for (int j = 0; j < 4; ++j) { const int n = (lane >> 3) + 8 * j; const float* s = scr + (8 * c8) * 33 + n;
        u32x4 o; o.x = pk2(s[0 * 33], s[1 * 33]); o.y = pk2(s[2 * 33], s[3 * 33]); o.z = pk2(s[4 * 33], s[5 * 33]); o.w = pk2(s[6 * 33], s[7 * 33]);
        *(u32x4*)(WT + (size_t)(destrow0 + n) * K + k0 + 8 * c8) = o; }
    asm volatile("s_waitcnt lgkmcnt(0)" ::: "memory");
}
__device__ __forceinline__ void rms_row_to_bf16(const float* xrow, const float* w, bf16* orow, int lane) {
    f32x4 v[4]; float s = 0.f;
#pragma unroll
    for (int j = 0; j < 4; ++j) { v[j] = *(const f32x4*)(xrow + 4 * lane + 256 * j); s += (v[j].x * v[j].x + v[j].y * v[j].y) + (v[j].z * v[j].z + v[j].w * v[j].w); }
    const float r = 1.f / sqrtf(wave_sum(s) * (1.f / D) + EPS);
#pragma unroll
    for (int j = 0; j < 4; ++j) { const f32x4 ww = *(const f32x4*)(w + 4 * lane + 256 * j); const f32x4 o = v[j] * r * ww;
        u32x2 p; p.x = pk2(o.x, o.y); p.y = pk2(o.z, o.w); *(u32x2*)(orow + 4 * lane + 256 * j) = p; }
}
__device__ __forceinline__ void p0_prologue(const Params& P, unsigned char* sm, int gw, int NGW, int wave, int lane) {
    unsigned char* ws = P.ws;
    float* scr = (float*)(sm + wave * 16384);
    constexpr int I_GU = 16 * 176, I_D = 44 * 32, I_IN = 16 * 80, I_OUT = 16 * 32;
    constexpr int NITEMS = 2 * I_GU + 2 * I_D + I_IN + I_OUT;
    for (int it = gw; it < NITEMS; it += NGW) {
        int r = it;
        if (r < 2 * I_GU) {
            const int which = r / I_GU; r -= which * I_GU; const int kb = r / 176, gi = r % 176, pn = gi >> 3, sub = gi & 7;
            const float* W = which == 0 ? ((sub >> 2) ? P.wu1 : P.wg1) : ((sub >> 2) ? P.wu2 : P.wg2);
            transpose_item(W, FF, D, 128 * pn + 32 * (sub & 3), 32, (bf16*)(ws + (which == 0 ? WS_WGU1 : WS_WGU2)), 32 * gi, kb, scr, lane); continue; }
        r -= 2 * I_GU;
        if (r < 2 * I_D) { const int which = r / I_D; r -= which * I_D; const int kb = r / 32, gi = r % 32;
            transpose_item(which == 0 ? P.wd1 : P.wd2, D, FF, 32 * gi, 32, (bf16*)(ws + (which == 0 ? WS_WD1 : WS_WD2)), 32 * gi, kb, scr, lane); continue; }
        r -= 2 * I_D;
        if (r < I_IN) { const int kb = r / 80, gi = r % 80, pn = gi >> 3, sub = gi & 7, bj = sub >> 2, wc = sub & 3; int src, nv = 32;
            if (pn < 6) src = 256 * pn + 32 * sub;
            else if (pn < 8) src = 1552 + (4 * (pn - 6) + wc) * 64 + 32 * bj;
            else if (pn == 8) src = (wc < 2) ? 2064 + wc * 64 + 32 * bj : 2192 + (wc - 2) * 64 + 32 * bj;
            else { src = 1536; nv = (sub == 0) ? 16 : 0; }
            transpose_item(P.win, 2320, D, src, nv, (bf16*)(ws + WS_WIN), 32 * gi, kb, scr, lane); continue; }
        r -= I_IN;
        { const int kb = r / 32, gi = r % 32; transpose_item(P.wout, D, D, 32 * gi, 32, (bf16*)(ws + WS_WOUT), 32 * gi, kb, scr, lane); }
    }
    { float* rope = (float*)(ws + WS_ROPE); const int gt = gw * 64 + lane, NGT = NGW * 64;
      for (int e = gt; e < (SEQ + NMETA) * 32; e += NGT) { const int pos = e >> 5, dd = e & 31;
          const float inv = (float)(1.0 / pow(10000.0, (double)dd / 32.0)); const float ang = (float)pos * inv;
          double sn, cs; sincos((double)ang, &sn, &cs); rope[pos * 64 + dd] = (float)cs; rope[pos * 64 + 32 + dd] = (float)sn; } }
    bf16* A = (bf16*)(ws + WS_A);
    for (int m = gw; m < NRP; m += NGW) {
        if (m < NR) rms_row_to_bf16(m < NX ? P.x + (size_t)m * D : P.meta + (size_t)(m - NX) * D, P.n1pre, A + (size_t)m * D, lane);
        else {
#pragma unroll
            for (int j = 0; j < 4; ++j) *(u32x2*)(A + (size_t)m * D + 4 * lane + 256 * j) = (u32x2){0u, 0u};
        }
    }
}

template <bool HAS_NEXT>
__device__ __forceinline__ void rowpass(const bf16* Fb, const float* hx, const float* meta, int nrows, float scale, const float* wpost, const float* wnext, float* Hdst, bf16* Adst, int gw, int NGW, int lane) {
    for (int row = gw; row < nrows; row += NGW) {
        const float* hrow = row < NX ? hx + (size_t)row * D : meta + (size_t)(row - NX) * D;
        f32x4 h[4], f[4]; float ss = 0.f;
#pragma unroll
        for (int j = 0; j < 4; ++j) { const u32x2 fb = *(const u32x2*)(Fb + (size_t)row * D + 4 * lane + 256 * j);
            f[j] = (f32x4){bf2f((unsigned short)(fb.x & 0xffffu)), bf2f((unsigned short)(fb.x >> 16)), bf2f((unsigned short)(fb.y & 0xffffu)), bf2f((unsigned short)(fb.y >> 16))};
            h[j] = *(const f32x4*)(hrow + 4 * lane + 256 * j);
            ss += (f[j].x * f[j].x + f[j].y * f[j].y) + (f[j].z * f[j].z + f[j].w * f[j].w); }
        const float r = scale / sqrtf(wave_sum(ss) * (1.f / D) + EPS);
        float s2 = 0.f;
#pragma unroll
        for (int j = 0; j < 4; ++j) { const f32x4 w = *(const f32x4*)(wpost + 4 * lane + 256 * j); h[j] = h[j] + f[j] * r * w;
            s2 += (h[j].x * h[j].x + h[j].y * h[j].y) + (h[j].z * h[j].z + h[j].w * h[j].w); }
        if (Hdst && row < NX) {
#pragma unroll
            for (int j = 0; j < 4; ++j) *(f32x4*)(Hdst + (size_t)row * D + 4 * lane + 256 * j) = h[j];
        }
        if (HAS_NEXT) {
            const float r2 = 1.f / sqrtf(wave_sum(s2) * (1.f / D) + EPS);
#pragma unroll
            for (int j = 0; j < 4; ++j) { const f32x4 w = *(const f32x4*)(wnext + 4 * lane + 256 * j); const f32x4 o = h[j] * r2 * w;
                u32x2 p; p.x = pk2(o.x, o.y); p.y = pk2(o.z, o.w); *(u32x2*)(Adst + (size_t)row * D + 4 * lane + 256 * j) = p; }
        }
    }
}

__device__ __forceinline__ void meta_down(const bf16* ACT, const bf16* Wd_t, bf16* F, unsigned char* sm, int wave, int lane) {
    const int g = blockIdx.x; if (g >= 64) return;
    const int fr = lane & 15, fq = lane >> 4;
    f32x4 acc = (f32x4){0.f, 0.f, 0.f, 0.f};
    const bf16* ap = ACT + (size_t)(NX + fr) * FF + wave * 352 + 8 * fq;
    const bf16* bp = Wd_t + (size_t)(16 * g + fr) * FF + wave * 352 + 8 * fq;
#pragma unroll
    for (int s = 0; s < 11; ++s) { const bf16x8 a = *(const bf16x8*)(ap + 32 * s), b = *(const bf16x8*)(bp + 32 * s); acc = mma16(b, a, acc); }
    f32x4* red = (f32x4*)sm;
    red[wave * 64 + lane] = acc;
    __syncthreads();
    if (wave == 0) { f32x4 t = red[lane];
#pragma unroll
        for (int w = 1; w < 8; ++w) t = t + red[w * 64 + lane];
        u32x2 p; p.x = pk2(t.x, t.y); p.y = pk2(t.z, t.w); *(u32x2*)(F + (size_t)(NX + fr) * D + 16 * g + 4 * fq) = p; }
    __syncthreads();
}

__device__ __forceinline__ int gla_row(int b, int c, int t) { return c == 0 ? (t < 48 ? -1 : NX + t - 48) : b * SEQ + (c - 1) * 64 + t; }
constexpr int GL_L = 0, GL_TOT = 16384, GL_GAS = 18432, GL_WA = 22528, GL_BIAS = 26624, GL_QS = 26880, GL_KS = 36096, GL_PS = 45312, GL_VT = 54528, GL_SS = 72960;
__device__ __forceinline__ void gla_cumlog(const Params& P, const float* GA, unsigned char* sm, int b, int h, int c, int tid) {
    float* L = (float*)(sm + GL_L); float* TOT = (float*)(sm + GL_TOT); float* GAS = (float*)(sm + GL_GAS); float* WA = (float*)(sm + GL_WA); float* BIAS = (float*)(sm + GL_BIAS);
    for (int idx = tid; idx < 1024; idx += NTHREADS) { const int t = idx >> 4, r = idx & 15; const int row = gla_row(b, c, t); GAS[idx] = row >= 0 ? GA[(size_t)row * 16 + r] : 0.f; }
    for (int idx = tid; idx < 1024; idx += NTHREADS) { const int r = idx >> 6, d = idx & 63; WA[idx] = P.wa2[r * 256 + h * 64 + d]; }
    if (tid < 64) BIAS[tid] = P.ba[h * 64 + tid];
    __syncthreads();
    for (int idx = tid; idx < 4096; idx += NTHREADS) { const int t = idx >> 6, d = idx & 63; float z = BIAS[d];
#pragma unroll
        for (int r = 0; r < 16; ++r) z += GAS[t * 16 + r] * WA[r * 64 + d];
        const float la = -(fmaxf(-z, 0.f) + log1pf(expf(-fabsf(z)))) * (1.f / 16.f);
        L[idx] = (gla_row(b, c, t) >= 0) ? la : 0.f; }
    __syncthreads();
    { const int seg = tid >> 6, d = tid & 63; float run = 0.f;
#pragma unroll
      for (int i = 0; i < 8; ++i) { run += L[(8 * seg + i) * 64 + d]; L[(8 * seg + i) * 64 + d] = run; }
      TOT[seg * 64 + d] = run; }
    __syncthreads();
    { const int seg = tid >> 6, d = tid & 63; float off = 0.f;
      for (int s = 0; s < seg; ++s) off += TOT[s * 64 + d];
#pragma unroll
      for (int i = 0; i < 8; ++i) L[(8 * seg + i) * 64 + d] += off; }
    __syncthreads();
}
__device__ __forceinline__ void gla_phase_a(const Params& P, unsigned char* sm, int tid, int wave, int lane) {
    unsigned char* ws = P.ws;
    const bf16* GK = (const bf16*)(ws + WS_ACT + PO_GK); const bf16* GV = (const bf16*)(ws + WS_ACT + PO_GV); const float* GA = (const float*)(ws + WS_ACT + PO_GA);
    float* UT = (float*)(ws + WS_F); float* DL = (float*)(ws + WS_DL);
    float* L = (float*)(sm + GL_L); bf16* KT = (bf16*)(sm + GL_KS); bf16* VT = (bf16*)(sm + GL_VT);
    const int fr = lane & 15, fq = lane >> 4;
    for (int item = blockIdx.x; item < 1024; item += gridDim.x) {
        const int bh = item >> 7, c = item & 127, b = bh >> 2, h = bh & 3;
        gla_cumlog(P, GA, sm, b, h, c, tid);
        for (int idx = tid; idx < 4096; idx += NTHREADS) { const int j = idx >> 6, d = idx & 63; const int row = gla_row(b, c, j);
            const float kv = row >= 0 ? bf2f(GK[(size_t)row * 256 + h * 64 + d]) : 0.f;
            KT[d * 72 + j] = (bf16)f2bf(kv * expf(L[63 * 64 + d] - L[j * 64 + d])); }
        for (int idx = tid; idx < 8192; idx += NTHREADS) { const int j = idx >> 7, v = idx & 127; const int row = gla_row(b, c, j);
            VT[v * 72 + j] = row >= 0 ? GV[(size_t)row * 512 + h * 128 + v] : (bf16)0; }
        __syncthreads();
        f32x4 acc[4];
#pragma unroll
        for (int dt = 0; dt < 4; ++dt) acc[dt] = (f32x4){0.f, 0.f, 0.f, 0.f};
#pragma unroll
        for (int s = 0; s < 2; ++s) { const bf16x8 vf = *(const bf16x8*)(VT + (16 * wave + fr) * 72 + 32 * s + 8 * fq);
#pragma unroll
            for (int dt = 0; dt < 4; ++dt) { const bf16x8 kf = *(const bf16x8*)(KT + (16 * dt + fr) * 72 + 32 * s + 8 * fq); acc[dt] = mma16(kf, vf, acc[dt]); } }
        float* up = UT + (size_t)item * 8192 + (16 * wave + fr) * 64 + 4 * fq;
#pragma unroll
        for (int dt = 0; dt < 4; ++dt) *(f32x4*)(up + 16 * dt) = acc[dt];
        if (tid < 64) DL[item * 64 + tid] = expf(L[63 * 64 + tid]);
        __syncthreads();
    }
}
__device__ __forceinline__ void gla_phase_b(const Params& P, int tid) {
    unsigned char* ws = P.ws;
    const float* UT = (const float*)(ws + WS_F); const float* DL = (const float*)(ws + WS_DL); bf16* ST = (bf16*)(ws + WS_ST);
    if (tid >= 256) return;
    for (int e = blockIdx.x * 256 + tid; e < 65536; e += gridDim.x * 256) {
        const int bh = e >> 13, idx = e & 8191, d = idx & 63; float S = 0.f;
        for (int c0 = 0; c0 < 128; c0 += 16) { float u[16], dl[16];
#pragma unroll
            for (int k = 0; k < 16; ++k) { u[k] = UT[(size_t)(bh * 128 + c0 + k) * 8192 + idx]; dl[k] = DL[(bh * 128 + c0 + k) * 64 + d]; }
#pragma unroll
            for (int k = 0; k < 16; ++k) { S = dl[k] * S + u[k]; ST[(size_t)(bh * 128 + c0 + k) * 8192 + idx] = (bf16)f2bf(S); } }
    }
}
__device__ __forceinline__ void gla_phase_c(const Params& P, unsigned char* sm, int tid, int wave, int lane) {
    unsigned char* ws = P.ws;
    const bf16* GQ = (const bf16*)(ws + WS_ACT + PO_GQ); const bf16* GK = (const bf16*)(ws + WS_ACT + PO_GK); const bf16* GV = (const bf16*)(ws + WS_ACT + PO_GV);
    const bf16* GG = (const bf16*)(ws + WS_ACT + PO_GG); const float* GA = (const float*)(ws + WS_ACT + PO_GA);
    const bf16* ST = (const bf16*)(ws + WS_ST); bf16* MIX = (bf16*)(ws + WS_A);
    float* L = (float*)(sm + GL_L); bf16* QS = (bf16*)(sm + GL_QS); bf16* KS = (bf16*)(sm + GL_KS); bf16* PS = (bf16*)(sm + GL_PS); bf16* VT = (bf16*)(sm + GL_VT); float* SS = (float*)(sm + GL_SS);
    const int fr = lane & 15, fq = lane >> 4;
    for (int item = blockIdx.x; item < 1024; item += gridDim.x) {
        const int bh = item >> 7, xc = item & 127, b = bh >> 2, h = bh & 3; const int rowb = b * SEQ + xc * 64;
        gla_cumlog(P, GA, sm, b, h, xc + 1, tid);
        for (int idx = tid; idx < 4096; idx += NTHREADS) { const int i = idx >> 6, d = idx & 63; const float bb = L[idx];
            QS[i * 72 + d] = (bf16)f2bf(bf2f(GQ[(size_t)(rowb + i) * 256 + h * 64 + d]) * expf(bb) * 0.125f);
            KS[i * 72 + d] = (bf16)f2bf(bf2f(GK[(size_t)(rowb + i) * 256 + h * 64 + d]) * expf(-bb)); }
        for (int idx = tid; idx < 8192; idx += NTHREADS) { const int j = idx >> 7, v = idx & 127; VT[v * 72 + j] = GV[(size_t)(rowb + j) * 512 + h * 128 + v]; }
        __syncthreads();
#pragma unroll
        for (int tt2 = 0; tt2 < 2; ++tt2) { const int tt = wave + 8 * tt2, it = tt >> 2, jt = tt & 3; f32x4 a = (f32x4){0.f, 0.f, 0.f, 0.f};
            if (jt <= it) {
#pragma unroll
                for (int s = 0; s < 2; ++s) { const bf16x8 kf = *(const bf16x8*)(KS + (16 * jt + fr) * 72 + 32 * s + 8 * fq), qf = *(const bf16x8*)(QS + (16 * it + fr) * 72 + 32 * s + 8 * fq); a = mma16(kf, qf, a); }
                if (jt == it) {
#pragma unroll
                    for (int e = 0; e < 4; ++e) if (4 * fq + e > fr) a[e] = 0.f;
                }
            }
            u32x2 p; p.x = pk2(a[0], a[1]); p.y = pk2(a[2], a[3]); *(u32x2*)(PS + (16 * it + fr) * 72 + 16 * jt + 4 * fq) = p; }
        __syncthreads();
        f32x4 acc[4];
#pragma unroll
        for (int it = 0; it < 4; ++it) acc[it] = (f32x4){0.f, 0.f, 0.f, 0.f};
        const bf16* stp = ST + (size_t)item * 8192 + (16 * wave + fr) * 64 + 8 * fq;
#pragma unroll
        for (int s = 0; s < 2; ++s) { const bf16x8 vf = *(const bf16x8*)(VT + (16 * wave + fr) * 72 + 32 * s + 8 * fq); const bf16x8 sf = *(const bf16x8*)(stp + 32 * s);
#pragma unroll
            for (int it = 0; it < 4; ++it) { const bf16x8 pf = *(const bf16x8*)(PS + (16 * it + fr) * 72 + 32 * s + 8 * fq), qf = *(const bf16x8*)(QS + (16 * it + fr) * 72 + 32 * s + 8 * fq);
                acc[it] = mma16(vf, pf, acc[it]); acc[it] = mma16(sf, qf, acc[it]); } }
#pragma unroll
        for (int it = 0; it < 4; ++it) { float p = (acc[it][0] * acc[it][0] + acc[it][1] * acc[it][1]) + (acc[it][2] * acc[it][2] + acc[it][3] * acc[it][3]);
            p += __shfl_xor(p, 16); p += __shfl_xor(p, 32); if (fq == 0) SS[wave * 64 + 16 * it + fr] = p; }
        __syncthreads();
        const f32x4 gw4 = *(const f32x4*)(P.glanorm + 16 * wave + 4 * fq);
#pragma unroll
        for (int it = 0; it < 4; ++it) { const int i = 16 * it + fr; float tot = 0.f;
#pragma unroll
            for (int w = 0; w < 8; ++w) tot += SS[w * 64 + i];
            const float r = 1.f / sqrtf(tot * (1.f / 128.f) + EPS);
            const u32x2 gb = *(const u32x2*)(GG + (size_t)(rowb + i) * 512 + h * 128 + 16 * wave + 4 * fq);
            const f32x4 gg = (f32x4){bf2f((unsigned short)(gb.x & 0xffffu)), bf2f((unsigned short)(gb.x >> 16)), bf2f((unsigned short)(gb.y & 0xffffu)), bf2f((unsigned short)(gb.y >> 16))};
            const f32x4 o = acc[it] * r * gw4 * gg;
            u32x2 p; p.x = pk2(o.x, o.y); p.y = pk2(o.z, o.w); *(u32x2*)(MIX + (size_t)(rowb + i) * D + h * 128 + 16 * wave + 4 * fq) = p; }
        __syncthreads();
    }
}

constexpr int SW_KS = 0, SW_KROW = 72, SW_VT = 2 * 208 * 72 * 2  , SW_VROW = 212, SW_SS = SW_VT + 2 * 64 * 212 * 2  ;
static_assert(SW_SS + 2048 <= 131072, "swa lds");
__device__ __forceinline__ void swa_phase(const Params& P, unsigned char* sm, int tid, int wave, int lane) {
    unsigned char* ws = P.ws;
    const bf16* SQ = (const bf16*)(ws + WS_ACT + PO_SQ); const bf16* SK = (const bf16*)(ws + WS_ACT + PO_SK); const bf16* SV = (const bf16*)(ws + WS_ACT + PO_SV);
    bf16* MIX = (bf16*)(ws + WS_A);
    bf16* Ks = (bf16*)(sm + SW_KS); bf16* VTs = (bf16*)(sm + SW_VT); float* SS = (float*)(sm + SW_SS);
    const int fr = lane & 15, fq = lane >> 4, hq = wave, kvh = wave >> 2;
    const float sink = P.sinks[hq];
    constexpr float LOG2E = 1.4426950408889634f;
    for (int item = blockIdx.x; item < 256; item += gridDim.x) {
        const int b = item >> 7, t0 = (item & 127) * 64, rowb = b * SEQ;
        for (int idx = tid; idx < 208 * 16; idx += NTHREADS) { const int kk = idx >> 4, ch = idx & 15, hd = ch >> 3, c8 = ch & 7;
            int row; if (kk < 192) { const int xk = t0 - 128 + kk; row = xk >= 0 ? rowb + xk : -1; } else row = NX + kk - 192;
            u32x4 kq = (u32x4){0u, 0u, 0u, 0u}, vq = kq;
            if (row >= 0) { kq = *(const u32x4*)(SK + (size_t)row * 128 + hd * 64 + c8 * 8); vq = *(const u32x4*)(SV + (size_t)row * 128 + hd * 64 + c8 * 8); }
            *(u32x4*)(Ks + (hd * 208 + kk) * SW_KROW + c8 * 8) = kq;
            bf16* vp = VTs + (hd * 64 + c8 * 8) * SW_VROW + kk;
            vp[0 * SW_VROW] = (bf16)(vq.x & 0xffffu); vp[1 * SW_VROW] = (bf16)(vq.x >> 16); vp[2 * SW_VROW] = (bf16)(vq.y & 0xffffu); vp[3 * SW_VROW] = (bf16)(vq.y >> 16);
            vp[4 * SW_VROW] = (bf16)(vq.z & 0xffffu); vp[5 * SW_VROW] = (bf16)(vq.z >> 16); vp[6 * SW_VROW] = (bf16)(vq.w & 0xffffu); vp[7 * SW_VROW] = (bf16)(vq.w >> 16); }
        __syncthreads();
        f32x4 o[4][4];
#pragma unroll
        for (int g = 0; g < 4; ++g) {
            const bf16* qp = SQ + (size_t)(rowb + t0 + 16 * g + fr) * 512 + hq * 64 + 8 * fq;
            const bf16x8 q0 = *(const bf16x8*)qp, q1 = *(const bf16x8*)(qp + 32);
            f32x4 s[10];
#pragma unroll
            for (int u = 0; u < 10; ++u) { const int k0 = (u < 9) ? 16 * (g + u) : 192; const bf16* kp = Ks + (kvh * 208 + k0 + fr) * SW_KROW + 8 * fq;
                const bf16x8 kf0 = *(const bf16x8*)kp, kf1 = *(const bf16x8*)(kp + 32);
                s[u] = mma16(kf0, q0, (f32x4){0.f, 0.f, 0.f, 0.f}); s[u] = mma16(kf1, q1, s[u]); }
            float mx = sink;
#pragma unroll
            for (int u = 0; u < 10; ++u)
#pragma unroll
                for (int e = 0; e < 4; ++e) { bool ok = true;
                    if (u == 0) ok = (4 * fq + e) > fr; if (u == 8) ok = (4 * fq + e) <= fr;
                    if (u < 9) ok = ok && (t0 - 128 + 16 * (g + u) + 4 * fq + e >= 0);
                    s[u][e] = ok ? s[u][e] : -1e30f; mx = fmaxf(mx, s[u][e]); }
            mx = fmaxf(mx, __shfl_xor(mx, 16)); mx = fmaxf(mx, __shfl_xor(mx, 32));
            float l = 0.f;
#pragma unroll
            for (int u = 0; u < 10; ++u)
#pragma unroll
                for (int e = 0; e < 4; ++e) { const float p = __builtin_amdgcn_exp2f((s[u][e] - mx) * LOG2E); s[u][e] = p; l += p; }
            l += __shfl_xor(l, 16); l += __shfl_xor(l, 32);
            l += __builtin_amdgcn_exp2f((sink - mx) * LOG2E);
            const float rl = 1.f / l;
#pragma unroll
            for (int dt = 0; dt < 4; ++dt) o[g][dt] = (f32x4){0.f, 0.f, 0.f, 0.f};
#pragma unroll
            for (int st = 0; st < 5; ++st) { const int ka = 16 * (g + 2 * st), kb = (st < 4) ? 16 * (g + 2 * st + 1) : 192;
                bf16x8 pf; { const unsigned p0 = pk2(s[2 * st][0], s[2 * st][1]), p1 = pk2(s[2 * st][2], s[2 * st][3]), p2 = pk2(s[2 * st + 1][0], s[2 * st + 1][1]), p3 = pk2(s[2 * st + 1][2], s[2 * st + 1][3]);
                    pf = __builtin_bit_cast(bf16x8, (u32x4){p0, p1, p2, p3}); }
#pragma unroll
                for (int dt = 0; dt < 4; ++dt) { const bf16* vp = VTs + (kvh * 64 + 16 * dt + fr) * SW_VROW + 4 * fq;
                    const u32x2 va = *(const u32x2*)(vp + ka), vb = *(const u32x2*)(vp + kb);
                    const bf16x8 vf = __builtin_bit_cast(bf16x8, (u32x4){va.x, va.y, vb.x, vb.y});
                    o[g][dt] = mma16(vf, pf, o[g][dt]); } }
            float ssq = 0.f;
#pragma unroll
            for (int dt = 0; dt < 4; ++dt) { o[g][dt] = o[g][dt] * rl; ssq += (o[g][dt][0] * o[g][dt][0] + o[g][dt][1] * o[g][dt][1]) + (o[g][dt][2] * o[g][dt][2] + o[g][dt][3] * o[g][dt][3]); }
            ssq += __shfl_xor(ssq, 16); ssq += __shfl_xor(ssq, 32);
            if (fq == 0) SS[wave * 64 + 16 * g + fr] = ssq;
        }
        __syncthreads();
#pragma unroll
        for (int g = 0; g < 4; ++g) { const int i = 16 * g + fr; float tot = 0.f;
#pragma unroll
            for (int w = 0; w < 8; ++w) tot += SS[w * 64 + i];
            const float r = 1.f / sqrtf(tot * (1.f / 512.f) + EPS);
#pragma unroll
            for (int dt = 0; dt < 4; ++dt) { const f32x4 w4 = *(const f32x4*)(P.swanorm + hq * 64 + 16 * dt + 4 * fq); const f32x4 ov = o[g][dt] * r * w4;
                u32x2 p; p.x = pk2(ov.x, ov.y); p.y = pk2(ov.z, ov.w); *(u32x2*)(MIX + (size_t)(rowb + t0 + i) * D + 512 + hq * 64 + 16 * dt + 4 * fq) = p; } }
        __syncthreads();
    }
}

__global__ void __launch_bounds__(NTHREADS, 2) hybrid_fwd(Params P) {
    extern __shared__ __attribute__((aligned(16))) unsigned char lds[];
    cg::grid_group grid = cg::this_grid();
    const int tid = threadIdx.x, lane = tid & 63, wave = __builtin_amdgcn_readfirstlane(tid >> 6);
    const int G = gridDim.x, gw = blockIdx.x * NWAVES + wave, NGW = G * NWAVES;
    unsigned char* ws = P.ws;
    PG8_LAS unsigned char* ring = (PG8_LAS unsigned char*)lds;
    bf16* A = (bf16*)(ws + WS_A); bf16* F = (bf16*)(ws + WS_F); bf16* ACT = (bf16*)(ws + WS_ACT);

    p0_prologue(P, lds, gw, NGW, wave, lane);
    grid.sync();
    { pg8::Gemm g{A, (const bf16*)(ws + WS_WGU1), NRP, NGU, D}; pg8::StaticOrder S; S.init(NRP, NGU, G, (int)blockIdx.x); pg8::EpiSwiglu E{ACT, FF};
      pg8::gemm_phase<pg8::EpiSwiglu, pg8::StaticOrder, true, true>(ring, g, S, E); }
    grid.sync();
    { meta_down(ACT, (const bf16*)(ws + WS_WD1), F, lds, wave, lane);
      pg8::Gemm g{ACT, (const bf16*)(ws + WS_WD1), NX, D, FF}; pg8::StaticOrder S; S.init(NX, D, G, (int)blockIdx.x); pg8::EpiPlain E{F, D};
      pg8::gemm_phase<pg8::EpiPlain, pg8::StaticOrder, true, true>(ring, g, S, E); }
    grid.sync();
    rowpass<true>(F, P.x, P.meta, NR, 0.5f, P.n1post, P.nmixpre, P.out, A, gw, NGW, lane);
    grid.sync();
    { pg8::Gemm g{A, (const bf16*)(ws + WS_WIN), NRP, NPROJ, D}; pg8::StaticOrder S; S.init(NRP, NPROJ, G, (int)blockIdx.x);
      unsigned char* po = ws + WS_ACT;
      pg8::EpiProj E{(bf16*)(po + PO_GQ), (bf16*)(po + PO_GK), (bf16*)(po + PO_GV), (bf16*)(po + PO_GG), (bf16*)(po + PO_SQ), (bf16*)(po + PO_SK), (bf16*)(po + PO_SV), (float*)(po + PO_GA), (const float*)(ws + WS_ROPE)};
      pg8::gemm_phase<pg8::EpiProj, pg8::StaticOrder, true, true>(ring, g, S, E); }
    grid.sync();
    swa_phase(P, lds, tid, wave, lane);
    gla_phase_a(P, lds, tid, wave, lane);
    grid.sync();
    gla_phase_b(P, tid);
    grid.sync();
    gla_phase_c(P, lds, tid, wave, lane);
    grid.sync();
    { pg8::Gemm g{A, (const bf16*)(ws + WS_WOUT), NX, D, D}; pg8::StaticOrder S; S.init(NX, D, G, (int)blockIdx.x); pg8::EpiPlain E{F, D};
      pg8::gemm_phase<pg8::EpiPlain, pg8::StaticOrder, true, true>(ring, g, S, E); }
    grid.sync();
    rowpass<true>(F, P.out, P.meta, NX, 1.0f, P.nmixpost, P.n2pre, P.out, A, gw, NGW, lane);
    grid.sync();
    { pg8::Gemm g{A, (const bf16*)(ws + WS_WGU2), NX, NGU, D}; pg8::StaticOrder S; S.init(NX, NGU, G, (int)blockIdx.x); pg8::EpiSwiglu E{ACT, FF};
      pg8::gemm_phase<pg8::EpiSwiglu, pg8::StaticOrder, true, true>(ring, g, S, E); }
    grid.sync();
    { pg8::Gemm g{ACT, (const bf16*)(ws + WS_WD2), NX, D, FF}; pg8::StaticOrder S; S.init(NX, D, G, (int)blockIdx.x); pg8::EpiPlain E{F, D};
      pg8::gemm_phase<pg8::EpiPlain, pg8::StaticOrder, true, true>(ring, g, S, E); }
    grid.sync();
    rowpass<false>(F, P.out, P.meta, NX, 0.5f, P.n2post, nullptr, P.out, nullptr, gw, NGW, lane);
}

extern "C" void kernel_launch(void* const* d_in, const int* in_sizes, int n_in, void* d_out, int out_size, void* d_ws, size_t ws_size, hipStream_t stream) {
    static int grid = 0;
    if (grid == 0) {
        if (n_in != 21 || in_sizes[0] != NX * D || out_size != NX * D || ws_size < WS_END) { fprintf(stderr, "kernel_launch: unexpected problem shape (n_in %d, ws %zu)\n", n_in, ws_size); grid = -1; return; }
        int dev = 0, cus = 0, per_cu = 0;
        (void)hipGetDevice(&dev); (void)hipDeviceGetAttribute(&cus, hipDeviceAttributeMultiprocessorCount, dev);
        if (hipFuncSetAttribute((const void*)hybrid_fwd, hipFuncAttributeMaxDynamicSharedMemorySize, LDS_BYTES) != hipSuccess) { fprintf(stderr, "kernel_launch: hipFuncSetAttribute failed\n"); grid = -1; return; }
        if (hipOccupancyMaxActiveBlocksPerMultiprocessor(&per_cu, (const void*)hybrid_fwd, NTHREADS, LDS_BYTES) != hipSuccess || per_cu < 1) { fprintf(stderr, "kernel_launch: occupancy query says %d\n", per_cu); per_cu = 1; }
        (void)hipGetLastError();
        grid = cus;
    }
    if (grid < 0) return;
    Params p{};
    const float** pp = (const float**)&p;
    for (int i = 0; i < 21; ++i) pp[i] = (const float*)d_in[i];
    p.out = (float*)d_out; p.ws = (unsigned char*)d_ws;
    void* args[] = {&p};
    hipError_t e = hipLaunchCooperativeKernel((const void*)hybrid_fwd, dim3(grid), dim3(NTHREADS), args, LDS_BYTES, stream);
    if (e != hipSuccess) fprintf(stderr, "cooperative launch failed: %s (grid %d)\n", hipGetErrorString(e), grid);
}
```

```cpp
#include <hip/hip_runtime.h>
#include <hip/hip_cooperative_groups.h>
#include <cstdio>
#include <cstdint>
#include <cmath>
namespace pg8 {
#define PG8_LAS __attribute__((address_space(3)))
typedef unsigned short bf16_t;
typedef short bf16x8 __attribute__((ext_vector_type(8)));
typedef float f32x4 __attribute__((ext_vector_type(4)));
typedef unsigned u32x4 __attribute__((ext_vector_type(4)));
constexpr int BM = 256, BK = 64, HALF = 128, HTB = HALF * BK * 2  , STAGE_BYTES = 8 * HTB, NXCD = 8, WGM = 8;

__host__ __device__ __forceinline__ int lds_byte(int r, int c) { const int st = (r >> 4) * 2 + (c >> 5), rr = r & 15, cc = c & 31, ob = rr * 64 + cc * 2; return st * 1024 + (ob ^ (((ob >> 9) & 1) << 5)); }
__host__ __device__ __forceinline__ void stage_rc(int b, int& R, int& C) { const int st = b / 1024, sb = b % 1024, swz = sb ^ (((sb >> 9) & 1) << 5); R = (st >> 1) * 16 + swz / 64; C = (st & 1) * 32 + (swz % 64) / 2; }
__host__ __device__ __forceinline__ int perm32(int rho) { const int n = rho >> 4, i = rho & 15; return 8 * (i >> 2) + 4 * n + (i & 3); }

struct Unit { int pm, pn; };
struct Gemm { const bf16_t* A; const bf16_t* Bt; int M, N, K; };

struct StaticOrder {
    int nM, nN, nwg, G, c;
    __host__ __device__ void init(int M, int N, int G_, int c_) { nM = M / BM; nN = N / BM; nwg = nM * nN; G = G_; c = c_; }
    __host__ __device__ bool next(int i, Unit& u) const {
        const long L = (long)i * G + c; if (L >= nwg) return false;
        int wgid = (int)L; { const int q = nwg / NXCD, r = nwg % NXCD, xcd = wgid % NXCD, off = wgid / NXCD; wgid = (xcd < r ? xcd * (q + 1) : r * (q + 1) + (xcd - r) * q) + off; }
        const int nig = WGM * nN, gid = wgid / nig, fm = gid * WGM, gsz = (nM - fm) < WGM ? (nM - fm) : WGM;
        u.pm = fm + ((wgid % nig) % gsz); u.pn = (wgid % nig) / gsz; return true;
    }
    __device__ __forceinline__ void a_ready(const Unit&) const {}
    __device__ __forceinline__ void done(const Unit&) const {}
};

__device__ __forceinline__ unsigned cvt_pk_bf16(float lo, float hi) { unsigned r; asm volatile("v_cvt_pk_bf16_f32 %0, %1, %2" : "=v"(r) : "v"(lo), "v"(hi)); return r; }
__device__ __forceinline__ float silu_f(float x) { return x * __builtin_amdgcn_rcpf(1.0f + __builtin_amdgcn_exp2f(-1.4426950408889634f * x)); }
struct EpiPlain {
    static constexpr bool PERM = true, AFTER_DRAIN = false;
    bf16_t* O; int ldc;
    __device__ __forceinline__ void operator()(const f32x4 (&acc)[2][2][4][2], const Unit& u, int wr, int wc, int fr, int fq) const {
        const int row0 = u.pm * BM + wr * 64 + fr, col0 = u.pn * BM + wc * 32 + 8 * fq;
#pragma unroll
        for (int ai = 0; ai < 2; ++ai)
#pragma unroll
            for (int m = 0; m < 4; ++m) { bf16_t* rowp = O + (size_t)(row0 + ai * HALF + m * 16) * ldc + col0;
#pragma unroll
                for (int bj = 0; bj < 2; ++bj) { const f32x4 v0 = acc[ai][bj][m][0], v1 = acc[ai][bj][m][1];
                    u32x4 w; w.x = cvt_pk_bf16(v0[0], v0[1]); w.y = cvt_pk_bf16(v0[2], v0[3]); w.z = cvt_pk_bf16(v1[0], v1[1]); w.w = cvt_pk_bf16(v1[2], v1[3]);
                    *(u32x4*)(rowp + bj * HALF) = w; } }
    }
};
struct EpiSwiglu {
    static constexpr bool PERM = true, AFTER_DRAIN = false;
    bf16_t* O; int ldc;
    __device__ __forceinline__ void operator()(const f32x4 (&acc)[2][2][4][2], const Unit& u, int wr, int wc, int fr, int fq) const {
        const int row0 = u.pm * BM + wr * 64 + fr, col0 = u.pn * HALF + wc * 32 + 8 * fq;
#pragma unroll
        for (int ai = 0; ai < 2; ++ai)
#pragma unroll
            for (int m = 0; m < 4; ++m) { bf16_t* rowp = O + (size_t)(row0 + ai * HALF + m * 16) * ldc + col0;
                const f32x4 g0 = acc[ai][0][m][0], g1 = acc[ai][0][m][1], u0 = acc[ai][1][m][0], u1 = acc[ai][1][m][1];
                u32x4 w; w.x = cvt_pk_bf16(silu_f(g0[0]) * u0[0], silu_f(g0[1]) * u0[1]); w.y = cvt_pk_bf16(silu_f(g0[2]) * u0[2], silu_f(g0[3]) * u0[3]);
                w.z = cvt_pk_bf16(silu_f(g1[0]) * u1[0], silu_f(g1[1]) * u1[1]); w.w = cvt_pk_bf16(silu_f(g1[2]) * u1[2], silu_f(g1[3]) * u1[3]);
                *(u32x4*)rowp = w; }
    }
};
struct EpiProj {
    static constexpr bool PERM = true, AFTER_DRAIN = false;
    bf16_t *GQ, *GK, *GV, *GG, *SQ, *SK, *SV; float* GA; const float* rope;
    __device__ __forceinline__ void operator()(const f32x4 (&acc)[2][2][4][2], const Unit& u, int wr, int wc, int fr, int fq) const {
        const int pn = u.pn, row0 = u.pm * BM + wr * 64 + fr;
        if (pn < 6) {
            bf16_t* base; int ld, coff;
            if (pn == 0) { base = GQ; ld = 256; coff = 0; } else if (pn == 1) { base = GK; ld = 256; coff = 0; }
            else if (pn < 4) { base = GV; ld = 512; coff = (pn - 2) * 256; } else { base = GG; ld = 512; coff = (pn - 4) * 256; }
            const bool act = pn >= 4;
#pragma unroll
            for (int ai = 0; ai < 2; ++ai)
#pragma unroll
                for (int m = 0; m < 4; ++m) { bf16_t* rowp = base + (size_t)(row0 + ai * HALF + m * 16) * ld + coff + wc * 32 + 8 * fq;
#pragma unroll
                    for (int bj = 0; bj < 2; ++bj) { f32x4 v0 = acc[ai][bj][m][0], v1 = acc[ai][bj][m][1];
                        if (act) { v0 = (f32x4){silu_f(v0[0]), silu_f(v0[1]), silu_f(v0[2]), silu_f(v0[3])}; v1 = (f32x4){silu_f(v1[0]), silu_f(v1[1]), silu_f(v1[2]), silu_f(v1[3])}; }
                        u32x4 w; w.x = cvt_pk_bf16(v0[0], v0[1]); w.y = cvt_pk_bf16(v0[2], v0[3]); w.z = cvt_pk_bf16(v1[0], v1[1]); w.w = cvt_pk_bf16(v1[2], v1[3]);
                        *(u32x4*)(rowp + bj * HALF) = w; } }
        } else if (pn < 9) {
            bf16_t* base; int ld, coff; float sc = 1.f; bool do_rope = true;
            if (pn < 8) { base = SQ; ld = 512; coff = (4 * (pn - 6) + wc) * 64; sc = 0.125f; }
            else if (wc < 2) { base = SK; ld = 128; coff = wc * 64; }
            else { base = SV; ld = 128; coff = (wc - 2) * 64; do_rope = false; }
#pragma unroll
            for (int ai = 0; ai < 2; ++ai)
#pragma unroll
                for (int m = 0; m < 4; ++m) { const int row = row0 + ai * HALF + m * 16; const int pos = row < 16384 ? (row & 8191) + 16 : row - 16384;
                    const float* rp = rope + (size_t)pos * 64 + 8 * fq;
                    f32x4 o1[2], o2[2];
#pragma unroll
                    for (int n = 0; n < 2; ++n) { const f32x4 x1 = acc[ai][0][m][n], x2 = acc[ai][1][m][n];
                        if (do_rope) { const f32x4 c = *(const f32x4*)(rp + 4 * n), s = *(const f32x4*)(rp + 32 + 4 * n); o1[n] = (x1 * c - x2 * s) * sc; o2[n] = (x2 * c + x1 * s) * sc; }
                        else { o1[n] = x1; o2[n] = x2; } }
                    bf16_t* rowp = base + (size_t)row * ld + coff + 8 * fq;
                    u32x4 w; w.x = cvt_pk_bf16(o1[0][0], o1[0][1]); w.y = cvt_pk_bf16(o1[0][2], o1[0][3]); w.z = cvt_pk_bf16(o1[1][0], o1[1][1]); w.w = cvt_pk_bf16(o1[1][2], o1[1][3]);
                    *(u32x4*)rowp = w;
                    w.x = cvt_pk_bf16(o2[0][0], o2[0][1]); w.y = cvt_pk_bf16(o2[0][2], o2[0][3]); w.z = cvt_pk_bf16(o2[1][0], o2[1][1]); w.w = cvt_pk_bf16(o2[1][2], o2[1][3]);
                    *(u32x4*)(rowp + 32) = w; }
        } else {
            if (wc == 0 && fq < 2) {
#pragma unroll
                for (int ai = 0; ai < 2; ++ai)
#pragma unroll
                    for (int m = 0; m < 4; ++m) { float* rowp = GA + (size_t)(row0 + ai * HALF + m * 16) * 16 + 8 * fq;
                        *(f32x4*)rowp = acc[ai][0][m][0]; *(f32x4*)(rowp + 4) = acc[ai][0][m][1]; }
            }
        }
    }
};

template <class Epi, class Sched, bool ALIGN_EPI = false, bool SP2 = false>
__device__ __forceinline__ void gemm_phase(PG8_LAS unsigned char* lds, const Gemm g, const Sched& S, const Epi& E) {
    int tid_ = threadIdx.x; asm volatile("" : "+v"(tid_));
    const int tid = tid_, wid = __builtin_amdgcn_readfirstlane(tid >> 6), lane = tid & 63, wr = wid >> 2, wc = wid & 3, fr = lane & 15, fq = lane >> 4;
    const int K = g.K, nt = K / BK;
    unsigned voffA[2], voffB[2];
#pragma unroll
    for (int i = 0; i < 2; ++i) { int R, C; stage_rc(tid * 16 + i * 8192, R, C); const int Rb = Epi::PERM ? ((R & ~31) + perm32(R & 31)) : R;
        voffA[i] = (unsigned)(R * K + C) * 2u; voffB[i] = (unsigned)(Rb * K + C) * 2u; }
    const size_t kstep = (size_t)(BK * 2);
    const size_t hstep = (size_t)HALF * K * 2;
    const size_t tstep = 2 * hstep;
    const unsigned ldsw = (unsigned)wid * 1024u;
    const int aoff = lds_byte(wr * 64 + fr, fq * 8), boff = lds_byte(wc * 32 + fr, fq * 8);
#define PG8_SA(b, h) (((b) * 2 + (h)) * HTB)
#define PG8_SB(b, h) ((4 + (b) * 2 + (h)) * HTB)
#define PG8_STAGE(bufoff, gbase, voff) do { _Pragma("unroll") for (int _i = 0; _i < 2; ++_i) \
        __builtin_amdgcn_global_load_lds((const unsigned*)((const char*)(gbase) + (voff)[_i]), (PG8_LAS unsigned*)(lds + (bufoff) + ldsw + _i * 8192), 16, 0, 0); } while (0)
#define PG8_LDA(dst, b, h) do { _Pragma("unroll") for (int m = 0; m < 4; ++m) _Pragma("unroll") for (int k = 0; k < 2; ++k) dst[m][k] = *(const PG8_LAS bf16x8*)(lds + PG8_SA(b, h) + aoff + m * 2048 + k * 1024); } while (0)
#define PG8_LDB(dst, b, h) do { _Pragma("unroll") for (int n = 0; n < 2; ++n) _Pragma("unroll") for (int k = 0; k < 2; ++k) dst[n][k] = *(const PG8_LAS bf16x8*)(lds + PG8_SB(b, h) + boff + n * 2048 + k * 1024); } while (0)
#define PG8_MMA(ai, bj, At, Bt) do { __builtin_amdgcn_s_setprio(1); _Pragma("unroll") for (int m = 0; m < 4; ++m) _Pragma("unroll") for (int n = 0; n < 2; ++n) _Pragma("unroll") for (int k = 0; k < 2; ++k) \
        acc[ai][bj][m][n] = __builtin_amdgcn_mfma_f32_16x16x32_bf16(Bt[n][k], At[m][k], acc[ai][bj][m][n], 0, 0, 0); __builtin_amdgcn_s_setprio(0); } while (0)
#define PG8_WAIT_V(n) asm volatile("s_waitcnt vmcnt(" #n ")" ::: "memory")
#define PG8_WAIT_L(n) asm volatile("s_waitcnt lgkmcnt(" #n ")" ::: "memory")
#define PG8_BAR __builtin_amdgcn_s_barrier()
#define PG8_SCHED __builtin_amdgcn_sched_barrier(0)
    Unit cur, nxt; int ui = 0;
    if (!S.next(0, cur)) return;
    f32x4 acc[2][2][4][2];
#pragma unroll
    for (int a = 0; a < 2; ++a)
#pragma unroll
        for (int b = 0; b < 2; ++b)
#pragma unroll
            for (int m = 0; m < 4; ++m)
#pragma unroll
                for (int n = 0; n < 2; ++n) acc[a][b][m][n] = (f32x4){0.f, 0.f, 0.f, 0.f};
    bf16x8 At[4][2], B0[2][2], B1[2][2];
    const char* cA = (const char*)g.A + (size_t)cur.pm * tstep; const char* cB = (const char*)g.Bt + (size_t)cur.pn * tstep;
    S.a_ready(cur);
    if constexpr (SP2) {
        PG8_STAGE(PG8_SB(0, 0), cB, voffB); PG8_STAGE(PG8_SB(0, 1), cB + hstep, voffB); PG8_STAGE(PG8_SA(0, 0), cA, voffA); PG8_STAGE(PG8_SA(0, 1), cA + hstep, voffA);
        if (wr == 1) PG8_BAR;
        PG8_WAIT_V(2); PG8_BAR;
        PG8_STAGE(PG8_SB(1, 0), cB + kstep, voffB); PG8_STAGE(PG8_SA(1, 0), cA + kstep, voffA); PG8_STAGE(PG8_SB(1, 1), cB + hstep + kstep, voffB);
        PG8_WAIT_V(6); PG8_BAR;
    } else {
        PG8_STAGE(PG8_SB(0, 0), cB, voffB); PG8_STAGE(PG8_SA(0, 0), cA, voffA); PG8_STAGE(PG8_SB(0, 1), cB + hstep, voffB); PG8_STAGE(PG8_SA(0, 1), cA + hstep, voffA);
        if (wr == 1) PG8_BAR;
        PG8_WAIT_V(4); PG8_BAR;
        PG8_STAGE(PG8_SB(1, 0), cB + kstep, voffB); PG8_STAGE(PG8_SA(1, 0), cA + kstep, voffA); PG8_STAGE(PG8_SB(1, 1), cB + hstep + kstep, voffB);
        PG8_WAIT_V(6); PG8_BAR;
    }
    for (;;) {
        const bool has_next = S.next(ui + 1, nxt);
        const char* nA = has_next ? (const char*)g.A + (size_t)nxt.pm * tstep : cA; const char* nB = has_next ? (const char*)g.Bt + (size_t)nxt.pn * tstep : cB;
        for (int t = 0; t < nt; t += 2) {
            const bool last = (t == nt - 2);
            const char* a1 = cA + (size_t)(t + 1) * kstep;
            const char* a2 = last ? nA : cA + (size_t)(t + 2) * kstep; const char* b2 = last ? nB : cB + (size_t)(t + 2) * kstep;
            const char* a3 = a2 + kstep; const char* b3 = b2 + kstep;
            if (last && has_next) S.a_ready(nxt);
            if constexpr (SP2) {
            PG8_LDB(B0, 0, 0); PG8_LDB(B1, 0, 1); PG8_SCHED; PG8_LDA(At, 0, 0); PG8_STAGE(PG8_SA(1, 1), a1 + hstep, voffA);
            PG8_WAIT_V(8); PG8_WAIT_L(0); PG8_BAR; PG8_MMA(0, 0, At, B0); PG8_MMA(0, 1, At, B1); PG8_BAR; PG8_SCHED;
            PG8_LDA(At, 0, 1); PG8_STAGE(PG8_SB(0, 0), b2, voffB); PG8_STAGE(PG8_SB(0, 1), b2 + hstep, voffB); PG8_STAGE(PG8_SA(0, 0), a2, voffA);
            PG8_WAIT_V(8); PG8_WAIT_L(0); PG8_BAR; PG8_MMA(1, 0, At, B0); PG8_MMA(1, 1, At, B1); PG8_BAR; PG8_SCHED;
            PG8_LDB(B0, 1, 0); PG8_LDB(B1, 1, 1); PG8_SCHED; PG8_LDA(At, 1, 0); PG8_STAGE(PG8_SA(0, 1), a2 + hstep, voffA);
            PG8_WAIT_V(8); PG8_WAIT_L(0); PG8_BAR; PG8_MMA(0, 0, At, B0); PG8_MMA(0, 1, At, B1); PG8_BAR; PG8_SCHED;
            PG8_LDA(At, 1, 1); PG8_STAGE(PG8_SB(1, 0), b3, voffB); PG8_STAGE(PG8_SB(1, 1), b3 + hstep, voffB); PG8_STAGE(PG8_SA(1, 0), a3, voffA);
            PG8_WAIT_V(8); PG8_WAIT_L(0); PG8_BAR; PG8_MMA(1, 0, At, B0); PG8_MMA(1, 1, At, B1); PG8_BAR; PG8_SCHED;
            } else {
            PG8_LDB(B0, 0, 0); PG8_SCHED; PG8_LDA(At, 0, 0); PG8_STAGE(PG8_SA(1, 1), a1 + hstep, voffA);
            PG8_WAIT_L(8); PG8_BAR; PG8_WAIT_L(0); PG8_MMA(0, 0, At, B0); PG8_BAR; PG8_SCHED;
            PG8_LDB(B1, 0, 1); PG8_STAGE(PG8_SB(0, 0), b2, voffB);
            PG8_BAR; PG8_WAIT_L(0); PG8_MMA(0, 1, At, B1); PG8_BAR;
            PG8_LDA(At, 0, 1); PG8_STAGE(PG8_SA(0, 0), a2, voffA);
            PG8_BAR; PG8_WAIT_L(0); PG8_MMA(1, 0, At, B0); PG8_BAR; PG8_SCHED;
            PG8_STAGE(PG8_SB(0, 1), b2 + hstep, voffB);
            PG8_WAIT_V(6); PG8_BAR; PG8_MMA(1, 1, At, B1); PG8_BAR;
            PG8_LDB(B0, 1, 0); PG8_SCHED; PG8_LDA(At, 1, 0); PG8_STAGE(PG8_SA(0, 1), a2 + hstep, voffA);
            PG8_WAIT_L(8); PG8_BAR; PG8_WAIT_L(0); PG8_MMA(0, 0, At, B0); PG8_BAR; PG8_SCHED;
            PG8_LDB(B1, 1, 1); PG8_STAGE(PG8_SB(1, 0), b3, voffB);
            PG8_BAR; PG8_WAIT_L(0); PG8_MMA(0, 1, At, B1); PG8_BAR;
            PG8_LDA(At, 1, 1); PG8_STAGE(PG8_SA(1, 0), a3, voffA);
            PG8_BAR; PG8_WAIT_L(0); PG8_MMA(1, 0, At, B0); PG8_BAR; PG8_SCHED;
            PG8_STAGE(PG8_SB(1, 1), b3 + hstep, voffB);
            PG8_WAIT_V(6); PG8_BAR; PG8_MMA(1, 1, At, B1); PG8_BAR;
            }
        }
        if constexpr (ALIGN_EPI) { if (wr == 0) PG8_BAR; }
        if constexpr (!Epi::AFTER_DRAIN) { E(acc, cur, wr, wc, fr, fq); S.done(cur); }
        if (!has_next) break;
#pragma unroll
        for (int a = 0; a < 2; ++a)
#pragma unroll
            for (int b = 0; b < 2; ++b)
#pragma unroll
                for (int m = 0; m < 4; ++m)
#pragma unroll
                    for (int n = 0; n < 2; ++n) acc[a][b][m][n] = (f32x4){0.f, 0.f, 0.f, 0.f};
        cur = nxt; cA = nA; cB = nB; ++ui;
        if constexpr (ALIGN_EPI) { if (wr == 1) PG8_BAR; }
    }
    PG8_WAIT_V(0);
    if constexpr (!ALIGN_EPI) { if (wr == 0) PG8_BAR; }
    PG8_BAR;
    if constexpr (Epi::AFTER_DRAIN) { E.fused(acc, cur, wr, wc, fr, fq, lds, wid, lane); S.done(cur); }
#undef PG8_SA
#undef PG8_SB
#undef PG8_STAGE
#undef PG8_LDA
#undef PG8_LDB
#undef PG8_MMA
#undef PG8_WAIT_V
#undef PG8_WAIT_L
#undef PG8_BAR
#undef PG8_SCHED
}
}

namespace cg = cooperative_groups;
typedef unsigned short bf16;
typedef float f32x4 __attribute__((ext_vector_type(4)));
typedef short bf16x8 __attribute__((ext_vector_type(8)));
typedef short s16x4 __attribute__((ext_vector_type(4)));
typedef unsigned u32x2 __attribute__((ext_vector_type(2)));
typedef unsigned u32x4 __attribute__((ext_vector_type(4)));

constexpr int D = 1024, FF = 2816, SEQ = 8192, NX = 16384, NMETA = 16, NR = NX + NMETA, NRP = 16640;
constexpr int NGU = 2 * FF, NPROJ = 2560;
constexpr float EPS = 1e-6f;
constexpr int NTHREADS = 512, NWAVES = 8;
constexpr int LDS_BYTES = 147456;

constexpr size_t SZ_WGU = (size_t)NGU * D * 2, SZ_WD = (size_t)D * FF * 2, SZ_WIN = (size_t)NPROJ * D * 2, SZ_WOUT = (size_t)D * D * 2;
constexpr size_t WS_WGU1 = 0, WS_WD1 = WS_WGU1 + SZ_WGU, WS_WIN = WS_WD1 + SZ_WD, WS_WOUT = WS_WIN + SZ_WIN, WS_WGU2 = WS_WOUT + SZ_WOUT, WS_WD2 = WS_WGU2 + SZ_WGU;
constexpr size_t WS_ROPE = WS_WD2 + SZ_WD, SZ_ROPE = (size_t)(SEQ + NMETA) * 64 * 4;
constexpr size_t WS_DL = WS_ROPE + SZ_ROPE, SZ_DL = (size_t)8 * 128 * 64 * 4;
constexpr size_t WS_A = WS_DL + SZ_DL, SZ_A = (size_t)NRP * D * 2;
constexpr size_t WS_F = WS_A + SZ_A, SZ_F = SZ_A;
constexpr size_t WS_ST = WS_F + SZ_F, SZ_ST = (size_t)8 * 128 * 8192 * 2;
constexpr size_t WS_ACT = WS_ST + SZ_ST, SZ_ACT = (size_t)NRP * FF * 2;
constexpr size_t WS_CTL = WS_ACT + SZ_ACT, SZ_CTL = 16384;
constexpr size_t WS_END = WS_CTL + SZ_CTL;
static_assert(WS_END <= (size_t)256 * 1024 * 1024, "ws map");
static_assert((size_t)8 * 128 * 8192 * 4 <= SZ_F, "UT fits in F");
constexpr size_t PO_GQ = 0, PO_GK = PO_GQ + (size_t)NRP * 256 * 2, PO_GV = PO_GK + (size_t)NRP * 256 * 2, PO_GG = PO_GV + (size_t)NRP * 512 * 2,
                 PO_SQ = PO_GG + (size_t)NRP * 512 * 2, PO_SK = PO_SQ + (size_t)NRP * 512 * 2, PO_SV = PO_SK + (size_t)NRP * 128 * 2, PO_GA = PO_SV + (size_t)NRP * 128 * 2,
                 PO_END = PO_GA + (size_t)NRP * 16 * 4;
static_assert(PO_END <= SZ_ACT, "projection outputs fit in ACT");

struct Params {
    const float *x, *meta, *n1pre, *wg1, *wu1, *wd1, *n1post, *nmixpre, *win, *wa2, *ba, *glanorm, *sinks, *swanorm, *wout, *nmixpost, *n2pre, *wg2, *wu2, *wd2, *n2post;
    float* out; unsigned char* ws;
};

__device__ __forceinline__ unsigned f2bf(float f) { unsigned u = __builtin_bit_cast(unsigned, f); return (u + 0x7fffu + ((u >> 16) & 1u)) >> 16; }
__device__ __forceinline__ unsigned pk2(float lo, float hi) { return f2bf(lo) | (f2bf(hi) << 16); }
__device__ __forceinline__ float bf2f(unsigned short b) { return __builtin_bit_cast(float, (unsigned)b << 16); }
__device__ __forceinline__ float wave_sum(float v) {
#pragma unroll
    for (int o = 1; o < 64; o <<= 1) v += __shfl_xor(v, o);
    return v;
}
__device__ __forceinline__ f32x4 mma16(bf16x8 first, bf16x8 second, f32x4 c) { return __builtin_amdgcn_mfma_f32_16x16x32_bf16(first, second, c, 0, 0, 0); }

__device__ __forceinline__ void transpose_item(const float* W, int Nsrc, int K, int srccol, int nvalid, bf16* WT, int destrow0, int kb, float* scr, int lane) {
    const int k0 = 64 * kb, c = lane & 31;
#pragma unroll 8
    for (int i = 0; i < 32; ++i) { const int kk = 2 * i + (lane >> 5); scr[kk * 33 + c] = (c < nvalid) ? W[(size_t)(k0 + kk) * Nsrc + srccol + c] : 0.f; }
    asm volatile("s_waitcnt lgkmcnt(0)" ::: "memory");
    const int c8 = lane & 7;
#pragma unroll
    for (int j = 0; j < 4; ++j) { const int n = (lane >> 3) + 8 * j; const float* s = scr + (8 * c8) * 33 + n;
        u32x4 o; o.x = pk2(s[0 * 33], s[1 * 33]); o.y = pk2(s[2 * 33], s[3 * 33]); o.z = pk2(s[4 * 33], s[5 * 33]); o.w = pk2(s[6 * 33], s[7 * 33]);
        *(u32x4*)(WT + (size_t)(destrow0 + n) * K + k0 + 8 * c8) = o; }
    asm volatile("s_waitcnt lgkmcnt(0)" ::: "memory");
}
__device__ __forceinline__ void rms_row_to_bf16(const float* xrow, const float* w, bf16* orow, int lane) {
    f32x4 v[4]; float s = 0.f;
#pragma unroll
    for (int j = 0; j < 4; ++j) { v[j] = *(const f32x4*)(xrow + 4 * lane + 256 * j); s += (v[j].x * v[j].x + v[j].y * v[j].y) + (v[j].z * v[j].z + v[j].w * v[j].w); }
    const float r = 1.f / sqrtf(wave_sum(s) * (1.f / D) + EPS);
#pragma unroll
    for (int j = 0; j < 4; ++j) { const f32x4 ww = *(const f32x4*)(w + 4 * lane + 256 * j); const f32x4 o = v[j] * r * ww;
        u32x2 p; p.x = pk2(o.x, o.y); p.y = pk2(o.z, o.w); *(u32x2*)(orow + 4 * lane + 256 * j) = p; }
}
__device__ __forceinline__ void p0_prologue(const Params& P, unsigned char* sm, int gw, int NGW, int wave, int lane) {
    unsigned char* ws = P.ws;
    float* scr = (float*)(sm + wave * 16384);
    constexpr int I_GU = 16 * 176, I_D = 44 * 32, I_IN = 16 * 80, I_OUT = 16 * 32;
    constexpr int NITEMS = 2 * I_GU + 2 * I_D + I_IN + I_OUT;
    for (int it = gw; it < NITEMS; it += NGW) {
        int r = it;
        if (r < 2 * I_GU) {
            const int which = r / I_GU; r -= which * I_GU; const int kb = r / 176, gi = r % 176, pn = gi >> 3, sub = gi & 7;
            const float* W = which == 0 ? ((sub >> 2) ? P.wu1 : P.wg1) : ((sub >> 2) ? P.wu2 : P.wg2);
            transpose_item(W, FF, D, 128 * pn + 32 * (sub & 3), 32, (bf16*)(ws + (which == 0 ? WS_WGU1 : WS_WGU2)), 32 * gi, kb, scr, lane); continue; }
        r -= 2 * I_GU;
        if (r < 2 * I_D) { const int which = r / I_D; r -= which * I_D; const int kb = r / 32, gi = r % 32;
            transpose_item(which == 0 ? P.wd1 : P.wd2, D, FF, 32 * gi, 32, (bf16*)(ws + (which == 0 ? WS_WD1 : WS_WD2)), 32 * gi, kb, scr, lane); continue; }
        r -= 2 * I_D;
        if (r < I_IN) { const int kb = r / 80, gi = r % 80, pn = gi >> 3, sub = gi & 7, bj = sub >> 2, wc = sub & 3; int src, nv = 32;
            if (pn < 6) src = 256 * pn + 32 * sub;
            else if (pn < 8) src = 1552 + (4 * (pn - 6) + wc) * 64 + 32 * bj;
            else if (pn == 8) src = (wc < 2) ? 2064 + wc * 64 + 32 * bj : 2192 + (wc - 2) * 64 + 32 * bj;
            else { src = 1536; nv = (sub == 0) ? 16 : 0; }
            transpose_item(P.win, 2320, D, src, nv, (bf16*)(ws + WS_WIN), 32 * gi, kb, scr, lane); continue; }
        r -= I_IN;
        { const int kb = r / 32, gi = r % 32; transpose_item(P.wout, D, D, 32 * gi, 32, (bf16*)(ws + WS_WOUT), 32 * gi, kb, scr, lane); }
    }
    { float* rope = (float*)(ws + WS_ROPE); const int gt = gw * 64 + lane, NGT = NGW * 64;
      for (int e = gt; e < (SEQ + NMETA) * 32; e += NGT) { const int pos = e >> 5, dd = e & 31;
          const float inv = (float)(1.0 / pow(10000.0, (double)dd / 32.0)); const float ang = (float)pos * inv;
          double sn, cs; sincos((double)ang, &sn, &cs); rope[pos * 64 + dd] = (float)cs; rope[pos * 64 + 32 + dd] = (float)sn; } }
    bf16* A = (bf16*)(ws + WS_A);
    for (int m = gw; m < NRP; m += NGW) {
        if (m < NR) rms_row_to_bf16(m < NX ? P.x + (size_t)m * D : P.meta + (size_t)(m - NX) * D, P.n1pre, A + (size_t)m * D, lane);
        else {
#pragma unroll
            for (int j = 0; j < 4; ++j) *(u32x2*)(A + (size_t)m * D + 4 * lane + 256 * j) = (u32x2){0u, 0u};
        }
    }
}

template <bool HAS_NEXT>
__device__ __forceinline__ void rowpass(const bf16* Fb, const float* hx, const float* meta, int nrows, float scale, const float* wpost, const float* wnext, float* Hdst, bf16* Adst, int gw, int NGW, int lane) {
    for (int row = gw; row < nrows; row += NGW) {
        const float* hrow = row < NX ? hx + (size_t)row * D : meta + (size_t)(row - NX) * D;
        f32x4 h[4], f[4]; float ss = 0.f;
#pragma unroll
        for (int j = 0; j < 4; ++j) { const u32x2 fb = *(const u32x2*)(Fb + (size_t)row * D + 4 * lane + 256 * j);
            f[j] = (f32x4){bf2f((unsigned short)(fb.x & 0xffffu)), bf2f((unsigned short)(fb.x >> 16)), bf2f((unsigned short)(fb.y & 0xffffu)), bf2f((unsigned short)(fb.y >> 16))};
            h[j] = *(const f32x4*)(hrow + 4 * lane + 256 * j);
            ss += (f[j].x * f[j].x + f[j].y * f[j].y) + (f[j].z * f[j].z + f[j].w * f[j].w); }
        const float r = scale / sqrtf(wave_sum(ss) * (1.f / D) + EPS);
        float s2 = 0.f;
#pragma unroll
        for (int j = 0; j < 4; ++j) { const f32x4 w = *(const f32x4*)(wpost + 4 * lane + 256 * j); h[j] = h[j] + f[j] * r * w;
            s2 += (h[j].x * h[j].x + h[j].y * h[j].y) + (h[j].z * h[j].z + h[j].w * h[j].w); }
        if (Hdst && row < NX) {
#pragma unroll
            for (int j = 0; j < 4; ++j) *(f32x4*)(Hdst + (size_t)row * D + 4 * lane + 256 * j) = h[j];
        }
        if (HAS_NEXT) {
            const float r2 = 1.f / sqrtf(wave_sum(s2) * (1.f / D) + EPS);
#pragma unroll
            for (int j = 0; j < 4; ++j) { const f32x4 w = *(const f32x4*)(wnext + 4 * lane + 256 * j); const f32x4 o = h[j] * r2 * w;
                u32x2 p; p.x = pk2(o.x, o.y); p.y = pk2(o.z, o.w); *(u32x2*)(Adst + (size_t)row * D + 4 * lane + 256 * j) = p; }
        }
    }
}

__device__ __forceinline__ void meta_down(const bf16* ACT, const bf16* Wd_t, bf16* F, unsigned char* sm, int wave, int lane) {
    const int g = blockIdx.x; if (g >= 64) return;
    const int fr = lane & 15, fq = lane >> 4;
    f32x4 acc = (f32x4){0.f, 0.f, 0.f, 0.f};
    const bf16* ap = ACT + (size_t)(NX + fr) * FF + wave * 352 + 8 * fq;
    const bf16* bp = Wd_t + (size_t)(16 * g + fr) * FF + wave * 352 + 8 * fq;
#pragma unroll
    for (int s = 0; s < 11; ++s) { const bf16x8 a = *(const bf16x8*)(ap + 32 * s), b = *(const bf16x8*)(bp + 32 * s); acc = mma16(b, a, acc); }
    f32x4* red = (f32x4*)sm;
    red[wave * 64 + lane] = acc;
    __syncthreads();
    if (wave == 0) { f32x4 t = red[lane];
#pragma unroll
        for (int w = 1; w < 8; ++w) t = t + red[w * 64 + lane];
        u32x2 p; p.x = pk2(t.x, t.y); p.y = pk2(t.z, t.w); *(u32x2*)(F + (size_t)(NX + fr) * D + 16 * g + 4 * fq) = p; }
    __syncthreads();
}

__device__ __forceinline__ int gla_row(int b, int c, int t) { return c == 0 ? (t < 48 ? -1 : NX + t - 48) : b * SEQ + (c - 1) * 64 + t; }
constexpr int GL_L = 0, GL_TOT = 16384, GL_GAS = 18432, GL_WA = 22528, GL_BIAS = 26624, GL_QS = 26880, GL_KS = 36096, GL_PS = 45312, GL_VT = 54528, GL_SS = 72960;
__device__ __forceinline__ void gla_cumlog(const Params& P, const float* GA, unsigned char* sm, int b, int h, int c, int tid) {
    float* L = (float*)(sm + GL_L); float* TOT = (float*)(sm + GL_TOT); float* GAS = (float*)(sm + GL_GAS); float* WA = (float*)(sm + GL_WA); float* BIAS = (float*)(sm + GL_BIAS);
    for (int idx = tid; idx < 1024; idx += NTHREADS) { const int t = idx >> 4, r = idx & 15; const int row = gla_row(b, c, t); GAS[idx] = row >= 0 ? GA[(size_t)row * 16 + r] : 0.f; }
    for (int idx = tid; idx < 1024; idx += NTHREADS) { const int r = idx >> 6, d = idx & 63; WA[idx] = P.wa2[r * 256 + h * 64 + d]; }
    if (tid < 64) BIAS[tid] = P.ba[h * 64 + tid];
    __syncthreads();
    for (int idx = tid; idx < 4096; idx += NTHREADS) { const int t = idx >> 6, d = idx & 63; float z = BIAS[d];
#pragma unroll
        for (int r = 0; r < 16; ++r) z += GAS[t * 16 + r] * WA[r * 64 + d];
        const float la = -(fmaxf(-z, 0.f) + log1pf(expf(-fabsf(z)))) * (1.f / 16.f);
        L[idx] = (gla_row(b, c, t) >= 0) ? la : 0.f; }
    __syncthreads();
    { const int seg = tid >> 6, d = tid & 63; float run = 0.f;
#pragma unroll
      for (int i = 0; i < 8; ++i) { run += L[(8 * seg + i) * 64 + d]; L[(8 * seg + i) * 64 + d] = run; }
      TOT[seg * 64 + d] = run; }
    __syncthreads();
    { const int seg = tid >> 6, d = tid & 63; float off = 0.f;
      for (int s = 0; s < seg; ++s) off += TOT[s * 64 + d];
#pragma unroll
      for (int i = 0; i < 8; ++i) L[(8 * seg + i) * 64 + d] += off; }
    __syncthreads();
}
__device__ __forceinline__ void gla_phase_a(const Params& P, unsigned char* sm, int tid, int wave, int lane) {
    unsigned char* ws = P.ws;
    const bf16* GK = (const bf16*)(ws + WS_ACT + PO_GK); const bf16* GV = (const bf16*)(ws + WS_ACT + PO_GV); const float* GA = (const float*)(ws + WS_ACT + PO_GA);
    float* UT = (float*)(ws + WS_F); float* DL = (float*)(ws + WS_DL);
    float* L = (float*)(sm + GL_L); bf16* KT = (bf16*)(sm + GL_KS); bf16* VT = (bf16*)(sm + GL_VT);
    const int fr = lane & 15, fq = lane >> 4;
    for (int item = blockIdx.x; item < 1024; item += gridDim.x) {
        const int bh = item >> 7, c = item & 127, b = bh >> 2, h = bh & 3;
        gla_cumlog(P, GA, sm, b, h, c, tid);
        for (int idx = tid; idx < 4096; idx += NTHREADS) { const int j = idx >> 6, d = idx & 63; const int row = gla_row(b, c, j);
            const float kv = row >= 0 ? bf2f(GK[(size_t)row * 256 + h * 64 + d]) : 0.f;
            KT[d * 72 + j] = (bf16)f2bf(kv * expf(L[63 * 64 + d] - L[j * 64 + d])); }
        for (int idx = tid; idx < 8192; idx += NTHREADS) { const int j = idx >> 7, v = idx & 127; const int row = gla_row(b, c, j);
            VT[v * 72 + j] = row >= 0 ? GV[(size_t)row * 512 + h * 128 + v] : (bf16)0; }
        __syncthreads();
        f32x4 acc[4];
#pragma unroll
        for (int dt = 0; dt < 4; ++dt) acc[dt] = (f32x4){0.f, 0.f, 0.f, 0.f};
#pragma unroll
        for (int s = 0; s < 2; ++s) { const bf16x8 vf = *(const bf16x8*)(VT + (16 * wave + fr) * 72 + 32 * s + 8 * fq);
#pragma unroll
            for (int dt = 0; dt < 4; ++dt) { const bf16x8 kf = *(const bf16x8*)(KT + (16 * dt + fr) * 72 + 32 * s + 8 * fq); acc[dt] = mma16(kf, vf, acc[dt]); } }
        float* up = UT + (size_t)item * 8192 + (16 * wave + fr) * 64 + 4 * fq;
#pragma unroll
        for (int dt = 0; dt < 4; ++dt) *(f32x4*)(up + 16 * dt) = acc[dt];
        if (tid < 64) DL[item * 64 + tid] = expf(L[63 * 64 + tid]);
        __syncthreads();
    }
}
__device__ __forceinline__ void gla_phase_b(const Params& P, int tid) {
    unsigned char* ws = P.ws;
    const float* UT = (const float*)(ws + WS_F); const float* DL = (const float*)(ws + WS_DL); bf16* ST = (bf16*)(ws + WS_ST);
    if (tid >= 256) return;
    for (int e = blockIdx.x * 256 + tid; e < 65536; e += gridDim.x * 256) {
        const int bh = e >> 13, idx = e & 8191, d = idx & 63; float S = 0.f;
        for (int c0 = 0; c0 < 128; c0 += 16) { float u[16], dl[16];
#pragma unroll
            for (int k = 0; k < 16; ++k) { u[k] = UT[(size_t)(bh * 128 + c0 + k) * 8192 + idx]; dl[k] = DL[(bh * 128 + c0 + k) * 64 + d]; }
#pragma unroll
            for (int k = 0; k < 16; ++k) { S = dl[k] * S + u[k]; ST[(size_t)(bh * 128 + c0 + k) * 8192 + idx] = (bf16)f2bf(S); } }
    }
}
__device__ __forceinline__ void gla_phase_c(const Params& P, unsigned char* sm, int tid, int wave, int lane) {
    unsigned char* ws = P.ws;
    const bf16* GQ = (const bf16*)(ws + WS_ACT + PO_GQ); const bf16* GK = (const bf16*)(ws + WS_ACT + PO_GK); const bf16* GV = (const bf16*)(ws + WS_ACT + PO_GV);
    const bf16* GG = (const bf16*)(ws + WS_ACT + PO_GG); const float* GA = (const float*)(ws + WS_ACT + PO_GA);
    const bf16* ST = (const bf16*)(ws + WS_ST); bf16* MIX = (bf16*)(ws + WS_A);
    float* L = (float*)(sm + GL_L); bf16* QS = (bf16*)(sm + GL_QS); bf16* KS = (bf16*)(sm + GL_KS); bf16* PS = (bf16*)(sm + GL_PS); bf16* VT = (bf16*)(sm + GL_VT); float* SS = (float*)(sm + GL_SS);
    const int fr = lane & 15, fq = lane >> 4;
    for (int item = blockIdx.x; item < 1024; item += gridDim.x) {
        const int bh = item >> 7, xc = item & 127, b = bh >> 2, h = bh & 3; const int rowb = b * SEQ + xc * 64;
        gla_cumlog(P, GA, sm, b, h, xc + 1, tid);
        for (int idx = tid; idx < 4096; idx += NTHREADS) { const int i = idx >> 6, d = idx & 63; const float bb = L[idx];
            QS[i * 72 + d] = (bf16)f2bf(bf2f(GQ[(size_t)(rowb + i) * 256 + h * 64 + d]) * expf(bb) * 0.125f);
            KS[i * 72 + d] = (bf16)f2bf(bf2f(GK[(size_t)(rowb + i) * 256 + h * 64 + d]) * expf(-bb)); }
        for (int idx = tid; idx < 8192; idx += NTHREADS) { const int j = idx >> 7, v = idx & 127; VT[v * 72 + j] = GV[(size_t)(rowb + j) * 512 + h * 128 + v]; }
        __syncthreads();
#pragma unroll
        for (int tt2 = 0; tt2 < 2; ++tt2) { const int tt = wave + 8 * tt2, it = tt >> 2, jt = tt & 3; f32x4 a = (f32x4){0.f, 0.f, 0.f, 0.f};
            if (jt <= it) {
#pragma unroll
                for (int s = 0; s < 2; ++s) { const bf16x8 kf = *(const bf16x8*)(KS + (16 * jt + fr) * 72 + 32 * s + 8 * fq), qf = *(const bf16x8*)(QS + (16 * it + fr) * 72 + 32 * s + 8 * fq); a = mma16(kf, qf, a); }
                if (jt == it) {
#pragma unroll
                    for (int e = 0; e < 4; ++e) if (4 * fq + e > fr) a[e] = 0.f;
                }
            }
            u32x2 p; p.x = pk2(a[0], a[1]); p.y = pk2(a[2], a[3]); *(u32x2*)(PS + (16 * it + fr) * 72 + 16 * jt + 4 * fq) = p; }
        __syncthreads();
        f32x4 acc[4];
#pragma unroll
        for (int it = 0; it < 4; ++it) acc[it] = (f32x4){0.f, 0.f, 0.f, 0.f};
        const bf16* stp = ST + (size_t)item * 8192 + (16 * wave + fr) * 64 + 8 * fq;
#pragma unroll
        for (int s = 0; s < 2; ++s) { const bf16x8 vf = *(const bf16x8*)(VT + (16 * wave + fr) * 72 + 32 * s + 8 * fq); const bf16x8 sf = *(const bf16x8*)(stp + 32 * s);
#pragma unroll
            for (int it = 0; it < 4; ++it) { const bf16x8 pf = *(const bf16x8*)(PS + (16 * it + fr) * 72 + 32 * s + 8 * fq), qf = *(const bf16x8*)(QS + (16 * it + fr) * 72 + 32 * s + 8 * fq);
                acc[it] = mma16(vf, pf, acc[it]); acc[it] = mma16(sf, qf, acc[it]); } }
#pragma unroll
        for (int it = 0; it < 4; ++it) { float p = (acc[it][0] * acc[it][0] + acc[it][1] * acc[it][1]) + (acc[it][2] * acc[it][2] + acc[it][3] * acc[it][3]);
            p += __shfl_xor(p, 16); p += __shfl_xor(p, 32); if (fq == 0) SS[wave * 64 + 16 * it + fr] = p; }
        __syncthreads();
        const f32x4 gw4 = *(const f32x4*)(P.glanorm + 16 * wave + 4 * fq);
#pragma unroll
        for (int it = 0; it < 4; ++it) { const int i = 16 * it + fr; float tot = 0.f;
#pragma unroll
            for (int w = 0; w < 8; ++w) tot += SS[w * 64 + i];
            const float r = 1.f / sqrtf(tot * (1.f / 128.f) + EPS);
            const u32x2 gb = *(const u32x2*)(GG + (size_t)(rowb + i) * 512 + h * 128 + 16 * wave + 4 * fq);
            const f32x4 gg = (f32x4){bf2f((unsigned short)(gb.x & 0xffffu)), bf2f((unsigned short)(gb.x >> 16)), bf2f((unsigned short)(gb.y & 0xffffu)), bf2f((unsigned short)(gb.y >> 16))};
            const f32x4 o = acc[it] * r * gw4 * gg;
            u32x2 p; p.x = pk2(o.x, o.y); p.y = pk2(o.z, o.w); *(u32x2*)(MIX + (size_t)(rowb + i) * D + h * 128 + 16 * wave + 4 * fq) = p; }
        __syncthreads();
    }
}

constexpr int SW_KS = 0, SW_KROW = 72, SW_VT = 2 * 208 * 72 * 2  , SW_VROW = 212, SW_SS = SW_VT + 2 * 64 * 212 * 2  ;
static_assert(SW_SS + 2048 <= 131072, "swa lds");
__device__ __forceinline__ void swa_phase(const Params& P, unsigned char* sm, int tid, int wave, int lane) {
    unsigned char* ws = P.ws;
    const bf16* SQ = (const bf16*)(ws + WS_ACT + PO_SQ); const bf16* SK = (const bf16*)(ws + WS_ACT + PO_SK); const bf16* SV = (const bf16*)(ws + WS_ACT + PO_SV);
    bf16* MIX = (bf16*)(ws + WS_A);
    bf16* Ks = (bf16*)(sm + SW_KS); bf16* VTs = (bf16*)(sm + SW_VT); float* SS = (float*)(sm + SW_SS);
    const int fr = lane & 15, fq = lane >> 4, hq = wave, kvh = wave >> 2;
    const float sink = P.sinks[hq];
    constexpr float LOG2E = 1.4426950408889634f;
    for (int item = blockIdx.x; item < 256; item += gridDim.x) {
        const int b = item >> 7, t0 = (item & 127) * 64, rowb = b * SEQ;
        for (int idx = tid; idx < 208 * 16; idx += NTHREADS) { const int kk = idx >> 4, ch = idx & 15, hd = ch >> 3, c8 = ch & 7;
            int row; if (kk < 192) { const int xk = t0 - 128 + kk; row = xk >= 0 ? rowb + xk : -1; } else row = NX + kk - 192;
            u32x4 kq = (u32x4){0u, 0u, 0u, 0u}, vq = kq;
            if (row >= 0) { kq = *(const u32x4*)(SK + (size_t)row * 128 + hd * 64 + c8 * 8); vq = *(const u32x4*)(SV + (size_t)row * 128 + hd * 64 + c8 * 8); }
            *(u32x4*)(Ks + (hd * 208 + kk) * SW_KROW + c8 * 8) = kq;
            bf16* vp = VTs + (hd * 64 + c8 * 8) * SW_VROW + kk;
            vp[0 * SW_VROW] = (bf16)(vq.x & 0xffffu); vp[1 * SW_VROW] = (bf16)(vq.x >> 16); vp[2 * SW_VROW] = (bf16)(vq.y & 0xffffu); vp[3 * SW_VROW] = (bf16)(vq.y >> 16);
            vp[4 * SW_VROW] = (bf16)(vq.z & 0xffffu); vp[5 * SW_VROW] = (bf16)(vq.z >> 16); vp[6 * SW_VROW] = (bf16)(vq.w & 0xffffu); vp[7 * SW_VROW] = (bf16)(vq.w >> 16); }
        __syncthreads();
        f32x4 o[4][4];
#pragma unroll
        for (int g = 0; g < 4; ++g) {
            const bf16* qp = SQ + (size_t)(rowb + t0 + 16 * g + fr) * 512 + hq * 64 + 8 * fq;
            const bf16x8 q0 = *(const bf16x8*)qp, q1 = *(const bf16x8*)(qp + 32);
            f32x4 s[10];
#pragma unroll
            for (int u = 0; u < 10; ++u) { const int k0 = (u < 9) ? 16 * (g + u) : 192; const bf16* kp = Ks + (kvh * 208 + k0 + fr) * SW_KROW + 8 * fq;
                const bf16x8 kf0 = *(const bf16x8*)kp, kf1 = *(const bf16x8*)(kp + 32);
                s[u] = mma16(kf0, q0, (f32x4){0.f, 0.f, 0.f, 0.f}); s[u] = mma16(kf1, q1, s[u]); }
            float mx = sink;
#pragma unroll
            for (int u = 0; u < 10; ++u)
#pragma unroll
                for (int e = 0; e < 4; ++e) { bool ok = true;
                    if (u == 0) ok = (4 * fq + e) > fr; if (u == 8) ok = (4 * fq + e) <= fr;
                    if (u < 9) ok = ok && (t0 - 128 + 16 * (g + u) + 4 * fq + e >= 0);
                    s[u][e] = ok ? s[u][e] : -1e30f; mx = fmaxf(mx, s[u][e]); }
            mx = fmaxf(mx, __shfl_xor(mx, 16)); mx = fmaxf(mx, __shfl_xor(mx, 32));
            float l = 0.f;
#pragma unroll
            for (int u = 0; u < 10; ++u)
#pragma unroll
                for (int e = 0; e < 4; ++e) { const float p = __builtin_amdgcn_exp2f((s[u][e] - mx) * LOG2E); s[u][e] = p; l += p; }
            l += __shfl_xor(l, 16); l += __shfl_xor(l, 32);
            l += __builtin_amdgcn_exp2f((sink - mx) * LOG2E);
            const float rl = 1.f / l;
#pragma unroll
            for (int dt = 0; dt < 4; ++dt) o[g][dt] = (f32x4){0.f, 0.f, 0.f, 0.f};
#pragma unroll
            for (int st = 0; st < 5; ++st) { const int ka = 16 * (g + 2 * st), kb = (st < 4) ? 16 * (g + 2 * st + 1) : 192;
                bf16x8 pf; { const unsigned p0 = pk2(s[2 * st][0], s[2 * st][1]), p1 = pk2(s[2 * st][2], s[2 * st][3]), p2 = pk2(s[2 * st + 1][0], s[2 * st + 1][1]), p3 = pk2(s[2 * st + 1][2], s[2 * st + 1][3]);
                    pf = __builtin_bit_cast(bf16x8, (u32x4){p0, p1, p2, p3}); }
#pragma unroll
                for (int dt = 0; dt < 4; ++dt) { const bf16* vp = VTs + (kvh * 64 + 16 * dt + fr) * SW_VROW + 4 * fq;
                    const u32x2 va = *(const u32x2*)(vp + ka), vb = *(const u32x2*)(vp + kb);
                    const bf16x8 vf = __builtin_bit_cast(bf16x8, (u32x4){va.x, va.y, vb.x, vb.y});
                    o[g][dt] = mma16(vf, pf, o[g][dt]); } }
            float ssq = 0.f;
#pragma unroll
            for (int dt = 0; dt < 4; ++dt) { o[g][dt] = o[g][dt] * rl; ssq += (o[g][dt][0] * o[g][dt][0] + o[g][dt][1] * o[g][dt][1]) + (o[g][dt][2] * o[g][dt][2] + o[g][dt][3] * o[g][dt][3]); }
            ssq += __shfl_xor(ssq, 16); ssq += __shfl_xor(ssq, 32);
            if (fq == 0) SS[wave * 64 + 16 * g + fr] = ssq;
        }
        __syncthreads();
#pragma unroll
        for (int g = 0; g < 4; ++g) { const int i = 16 * g + fr; float tot = 0.f;
#pragma unroll
            for (int w = 0; w < 8; ++w) tot += SS[w * 64 + i];
            const float r = 1.f / sqrtf(tot * (1.f / 512.f) + EPS);
#pragma unroll
            for (int dt = 0; dt < 4; ++dt) { const f32x4 w4 = *(const f32x4*)(P.swanorm + hq * 64 + 16 * dt + 4 * fq); const f32x4 ov = o[g][dt] * r * w4;
                u32x2 p; p.x = pk2(ov.x, ov.y); p.y = pk2(ov.z, ov.w); *(u32x2*)(MIX + (size_t)(rowb + t0 + i) * D + 512 + hq * 64 + 16 * dt + 4 * fq) = p; } }
        __syncthreads();
    }
}

#define LAS __attribute__((address_space(3)))
#define XB_TMO      128
#define XB_XCNT(j)  (256  + 64 * (j))
#define XB_XSUB(j)  (1280 + 64 * (j))
#define XB_XGEN(j)  (2304 + 64 * (j))
#define XB_TOP      3328
#define XB_TOPGEN   3392
#define XCD_BAR_WORDS 3456
#define XB_SPIN_CAP (1u << 18)

__device__ __forceinline__ unsigned xb_ld(unsigned* p)              { return __hip_atomic_load(p, __ATOMIC_RELAXED, __HIP_MEMORY_SCOPE_AGENT); }
__device__ __forceinline__ unsigned xb_add(unsigned* p, unsigned v) { return __hip_atomic_fetch_add(p, v, __ATOMIC_RELAXED, __HIP_MEMORY_SCOPE_AGENT); }
__device__ __forceinline__ unsigned xb_xcc_id() { return (unsigned)__builtin_amdgcn_s_getreg((3 << 11) | 20) & 0xFu; }
#define XB_SPIN(cond, bar) do { unsigned _sp = 0; while (cond) { __builtin_amdgcn_s_sleep(1); \
    if ((++_sp & 255u) == 0u) { if (xb_ld(&(bar)[XB_TMO])) break; if (_sp > XB_SPIN_CAP) { atomicAdd(&(bar)[XB_TMO], 1u); break; } } } } while (0)

struct XcdBarrier {
    unsigned* bar; unsigned x;
    volatile LAS unsigned* st;
};

__device__ __forceinline__ XcdBarrier xcd_barrier_post(unsigned* bar, volatile LAS unsigned* st) {
    XcdBarrier b; b.bar = bar; b.x = xb_xcc_id(); b.st = st;
    if (threadIdx.x == 0) (void)xb_add(&bar[XB_XCNT(b.x)], 1u);
    return b;
}
__device__ __forceinline__ void xcd_barrier_complete(unsigned* bar, unsigned x, unsigned& nloc, unsigned& nx) {
    const unsigned G = gridDim.x * gridDim.y * gridDim.z;
    unsigned sum, cnt, mine, sp = 0u;
    for (;;) {
        sum = 0u; cnt = 0u; mine = 0u;
#pragma unroll
        for (unsigned j = 0; j < 16; ++j) { const unsigned c = xb_ld(&bar[XB_XCNT(j)]); sum += c; cnt += (c > 0u) ? 1u : 0u; mine = (j == x) ? c : mine; }
        if (sum == G) break;
        __builtin_amdgcn_s_sleep(1);
        if ((++sp & 255u) == 0u) { if (xb_ld(&bar[XB_TMO])) break; if (sp > XB_SPIN_CAP) { atomicAdd(&bar[XB_TMO], 1u); break; } }
    }
    nloc = mine > 0u ? mine : 1u; nx = cnt > 0u ? cnt : 1u;
}

__device__ __forceinline__ void xcd_barrier(const XcdBarrier& b) {
    asm volatile("s_waitcnt vmcnt(0)" ::: "memory");
    __syncthreads();
    if (threadIdx.x == 0) {
        unsigned* bar = b.bar;
        __builtin_amdgcn_s_waitcnt(0);
        unsigned nloc = b.st[0], nx = b.st[1];
        if (nloc == 0u) { xcd_barrier_complete(bar, b.x, nloc, nx); b.st[0] = nloc; b.st[1] = nx; }
        const unsigned old = xb_add(&bar[XB_XSUB(b.x)], 1u);
        const unsigned gen = old / nloc;
        if (old + 1u == (gen + 1u) * nloc) {
            __builtin_amdgcn_fence(__ATOMIC_RELEASE, "agent");
            asm volatile("s_waitcnt vmcnt(0)" ::: "memory");
            const unsigned og = xb_add(&bar[XB_TOP], 1u);
            const unsigned tg = og / nx;
            if (og + 1u == (tg + 1u) * nx) xb_add(&bar[XB_TOPGEN], 1u);
            else XB_SPIN(xb_ld(&bar[XB_TOPGEN]) == tg, bar);
            __builtin_amdgcn_fence(__ATOMIC_ACQUIRE, "agent");
            xb_add(&bar[XB_XGEN(b.x)], 1u);
            asm volatile("s_waitcnt vmcnt(0)" ::: "memory");
        } else {
            XB_SPIN(xb_ld(&bar[XB_XGEN(b.x)]) == gen, bar);
            __builtin_amdgcn_fence(__ATOMIC_ACQUIRE, "agent");
            asm volatile("s_waitcnt vmcnt(0)" ::: "memory");
        }
    }
    __syncthreads();
}
#ifndef REP_P0
#define REP_P0 1
#endif
#ifndef REP_SWA
#define REP_SWA 1
#endif
#ifndef REP_GA
#define REP_GA 1
#endif
#ifndef REP_GB
#define REP_GB 1
#endif
#ifndef REP_GC
#define REP_GC 1
#endif
#ifndef REP_P1
#define REP_P1 1
#endif
#ifndef REP_P3
#define REP_P3 1
#endif
#ifndef EXTRA_SYNC
#define EXTRA_SYNC 0
#endif
__global__ void __launch_bounds__(NTHREADS, 2) hybrid_fwd(Params P) {
    extern __shared__ __attribute__((aligned(16))) unsigned char lds[];
    cg::grid_group grid = cg::this_grid();
    const int tid = threadIdx.x, lane = tid & 63, wave = __builtin_amdgcn_readfirstlane(tid >> 6);
    const int G = gridDim.x, gw = blockIdx.x * NWAVES + wave, NGW = G * NWAVES;
    unsigned char* ws = P.ws;
    PG8_LAS unsigned char* ring = (PG8_LAS unsigned char*)lds;
    bf16* A = (bf16*)(ws + WS_A); bf16* F = (bf16*)(ws + WS_F); bf16* ACT = (bf16*)(ws + WS_ACT);

    if (tid < 2) ((volatile LAS unsigned*)(lds + 131072))[tid] = 0u;
    if (blockIdx.x == 0) for (int i = tid; i < (int)(SZ_CTL / 4); i += NTHREADS) __hip_atomic_store((unsigned*)(ws + WS_CTL) + i, 0u, __ATOMIC_RELAXED, __HIP_MEMORY_SCOPE_AGENT);
    for (int rep = 0; rep < REP_P0; ++rep) { p0_prologue(P, lds, gw, NGW, wave, lane); __syncthreads(); }
    grid.sync();
    (void)xcd_barrier_post((unsigned*)(ws + WS_CTL), (volatile LAS unsigned*)(lds + 131072));
#define GRID_BAR() do { XcdBarrier b_; b_.bar = (unsigned*)(P.ws + WS_CTL); b_.x = xb_xcc_id(); b_.st = (volatile LAS unsigned*)(lds + 131072); xcd_barrier(b_); } while (0)
    for (int rep = 0; rep < EXTRA_SYNC; ++rep) GRID_BAR();
    for (int rep = 0; rep < REP_P1; ++rep)
    { pg8::Gemm g{A, (const bf16*)(ws + WS_WGU1), NRP, NGU, D}; pg8::StaticOrder S; S.init(NRP, NGU, G, (int)blockIdx.x); pg8::EpiSwiglu E{ACT, FF};
      pg8::gemm_phase<pg8::EpiSwiglu, pg8::StaticOrder, true, true>(ring, g, S, E); }
    GRID_BAR();
    { meta_down(ACT, (const bf16*)(ws + WS_WD1), F, lds, wave, lane);
      pg8::Gemm g{ACT, (const bf16*)(ws + WS_WD1), NX, D, FF}; pg8::StaticOrder S; S.init(NX, D, G, (int)blockIdx.x); pg8::EpiPlain E{F, D};
      pg8::gemm_phase<pg8::EpiPlain, pg8::StaticOrder, true, true>(ring, g, S, E); }
    GRID_BAR();
    for (int rep = 0; rep < REP_P3; ++rep) rowpass<true>(F, P.x, P.meta, NR, 0.5f, P.n1post, P.nmixpre, P.out, A, gw, NGW, lane);
    GRID_BAR();
    { pg8::Gemm g{A, (const bf16*)(ws + WS_WIN), NRP, NPROJ, D}; pg8::StaticOrder S; S.init(NRP, NPROJ, G, (int)blockIdx.x);
      unsigned char* po = ws + WS_ACT;
      pg8::EpiProj E{(bf16*)(po + PO_GQ), (bf16*)(po + PO_GK), (bf16*)(po + PO_GV), (bf16*)(po + PO_GG), (bf16*)(po + PO_SQ), (bf16*)(po + PO_SK), (bf16*)(po + PO_SV), (float*)(po + PO_GA), (const float*)(ws + WS_ROPE)};
      pg8::gemm_phase<pg8::EpiProj, pg8::StaticOrder, true, true>(ring, g, S, E); }
    GRID_BAR();
    for (int rep = 0; rep < REP_SWA; ++rep) swa_phase(P, lds, tid, wave, lane);
    for (int rep = 0; rep < REP_GA; ++rep) gla_phase_a(P, lds, tid, wave, lane);
    GRID_BAR();
    for (int rep = 0; rep < REP_GB; ++rep) gla_phase_b(P, tid);
    GRID_BAR();
    for (int rep = 0; rep < REP_GC; ++rep) gla_phase_c(P, lds, tid, wave, lane);
    GRID_BAR();
    { pg8::Gemm g{A, (const bf16*)(ws + WS_WOUT), NX, D, D}; pg8::StaticOrder S; S.init(NX, D, G, (int)blockIdx.x); pg8::EpiPlain E{F, D};
      pg8::gemm_phase<pg8::EpiPlain, pg8::StaticOrder, true, true>(ring, g, S, E); }
    GRID_BAR();
    rowpass<true>(F, P.out, P.meta, NX, 1.0f, P.nmixpost, P.n2pre, P.out, A, gw, NGW, lane);
    GRID_BAR();
    { pg8::Gemm g{A, (const bf16*)(ws + WS_WGU2), NX, NGU, D}; pg8::StaticOrder S; S.init(NX, NGU, G, (int)blockIdx.x); pg8::EpiSwiglu E{ACT, FF};
      pg8::gemm_phase<pg8::EpiSwiglu, pg8::StaticOrder, true, true>(ring, g, S, E); }
    GRID_BAR();
    { pg8::Gemm g{ACT, (const bf16*)(ws + WS_WD2), NX, D, FF}; pg8::StaticOrder S; S.init(NX, D, G, (int)blockIdx.x); pg8::EpiPlain E{F, D};
      pg8::gemm_phase<pg8::EpiPlain, pg8::StaticOrder, true, true>(ring, g, S, E); }
    GRID_BAR();
    rowpass<false>(F, P.out, P.meta, NX, 0.5f, P.n2post, nullptr, P.out, nullptr, gw, NGW, lane);
}

extern "C" void kernel_launch(void* const* d_in, const int* in_sizes, int n_in, void* d_out, int out_size, void* d_ws, size_t ws_size, hipStream_t stream) {
    static int grid = 0;
    if (grid == 0) {
        if (n_in != 21 || in_sizes[0] != NX * D || out_size != NX * D || ws_size < WS_END) { fprintf(stderr, "kernel_launch: unexpected problem shape (n_in %d, ws %zu)\n", n_in, ws_size); grid = -1; return; }
        int dev = 0, cus = 0, per_cu = 0;
        (void)hipGetDevice(&dev); (void)hipDeviceGetAttribute(&cus, hipDeviceAttributeMultiprocessorCount, dev);
        if (hipFuncSetAttribute((const void*)hybrid_fwd, hipFuncAttributeMaxDynamicSharedMemorySize, LDS_BYTES) != hipSuccess) { fprintf(stderr, "kernel_launch: hipFuncSetAttribute failed\n"); grid = -1; return; }
        if (hipOccupancyMaxActiveBlocksPerMultiprocessor(&per_cu, (const void*)hybrid_fwd, NTHREADS, LDS_BYTES) != hipSuccess || per_cu < 1) { fprintf(stderr, "kernel_launch: occupancy query says %d\n", per_cu); per_cu = 1; }
        (void)hipGetLastError();
        grid = cus;
    }
    if (grid < 0) return;
    Params p{};
    const float** pp = (const float**)&p;
    for (int i = 0; i < 21; ++i) pp[i] = (const float*)d_in[i];
    p.out = (float*)d_out; p.ws = (unsigned char*)d_ws;
    void* args[] = {&p};
    hipError_t e = hipLaunchCooperativeKernel((const void*)hybrid_fwd, dim3(grid), dim3(NTHREADS), args, LDS_BYTES, stream);
    if (e != hipSuccess) fprintf(stderr, "cooperative launch failed: %s (grid %d)\n", hipGetErrorString(e), grid);
}
```

```cpp
#include <hip/hip_runtime.h>
#include <hip/hip_cooperative_groups.h>
#include <cstdio>
#include <cstdint>
#include <cmath>
namespace pg8 {
#define PG8_LAS __attribute__((address_space(3)))
typedef unsigned short bf16_t;
typedef short bf16x8 __attribute__((ext_vector_type(8)));
typedef float f32x4 __attribute__((ext_vector_type(4)));
typedef unsigned u32x4 __attribute__((ext_vector_type(4)));
constexpr int BM = 256, BK = 64, HALF = 128, HTB = HALF * BK * 2  , STAGE_BYTES = 8 * HTB, NXCD = 8, WGM = 8;

__host__ __device__ __forceinline__ int lds_byte(int r, int c) { const int st = (r >> 4) * 2 + (c >> 5), rr = r & 15, cc = c & 31, ob = rr * 64 + cc * 2; return st * 1024 + (ob ^ (((ob >> 9) & 1) << 5)); }
__host__ __device__ __forceinline__ void stage_rc(int b, int& R, int& C) { const int st = b / 1024, sb = b % 1024, swz = sb ^ (((sb >> 9) & 1) << 5); R = (st >> 1) * 16 + swz / 64; C = (st & 1) * 32 + (swz % 64) / 2; }
__host__ __device__ __forceinline__ int perm32(int rho) { const int n = rho >> 4, i = rho & 15; return 8 * (i >> 2) + 4 * n + (i & 3); }

struct Unit { int pm, pn; };
struct Gemm { const bf16_t* A; const bf16_t* Bt; int M, N, K; };

struct StaticOrder {
    int nM, nN, nwg, G, c;
    __host__ __device__ void init(int M, int N, int G_, int c_) { nM = M / BM; nN = N / BM; nwg = nM * nN; G = G_; c = c_; }
    __host__ __device__ bool next(int i, Unit& u) const {
        const long L = (long)i * G + c; if (L >= nwg) return false;
        int wgid = (int)L; { const int q = nwg / NXCD, r = nwg % NXCD, xcd = wgid % NXCD, off = wgid / NXCD; wgid = (xcd < r ? xcd * (q + 1) : r * (q + 1) + (xcd - r) * q) + off; }
        const int nig = WGM * nN, gid = wgid / nig, fm = gid * WGM, gsz = (nM - fm) < WGM ? (nM - fm) : WGM;
        u.pm = fm + ((wgid % nig) % gsz); u.pn = (wgid % nig) / gsz; return true;
    }
    __device__ __forceinline__ void a_ready(const Unit&) const {}
    __device__ __forceinline__ void done(const Unit&) const {}
};

__device__ __forceinline__ unsigned cvt_pk_bf16(float lo, float hi) { unsigned r; asm volatile("v_cvt_pk_bf16_f32 %0, %1, %2" : "=v"(r) : "v"(lo), "v"(hi)); return r; }
__device__ __forceinline__ float silu_f(float x) { return x * __builtin_amdgcn_rcpf(1.0f + __builtin_amdgcn_exp2f(-1.4426950408889634f * x)); }
struct EpiPlain {
    static constexpr bool PERM = true, AFTER_DRAIN = false;
    bf16_t* O; int ldc;
    __device__ __forceinline__ void operator()(const f32x4 (&acc)[2][2][4][2], const Unit& u, int wr, int wc, int fr, int fq) const {
        const int row0 = u.pm * BM + wr * 64 + fr, col0 = u.pn * BM + wc * 32 + 8 * fq;
#pragma unroll
        for (int ai = 0; ai < 2; ++ai)
#pragma unroll
            for (int m = 0; m < 4; ++m) { bf16_t* rowp = O + (size_t)(row0 + ai * HALF + m * 16) * ldc + col0;
#pragma unroll
                for (int bj = 0; bj < 2; ++bj) { const f32x4 v0 = acc[ai][bj][m][0], v1 = acc[ai][bj][m][1];
                    u32x4 w; w.x = cvt_pk_bf16(v0[0], v0[1]); w.y = cvt_pk_bf16(v0[2], v0[3]); w.z = cvt_pk_bf16(v1[0], v1[1]); w.w = cvt_pk_bf16(v1[2], v1[3]);
                    *(u32x4*)(rowp + bj * HALF) = w; } }
    }
};
struct EpiSwiglu {
    static constexpr bool PERM = true, AFTER_DRAIN = false;
    bf16_t* O; int ldc;
    __device__ __forceinline__ void operator()(const f32x4 (&acc)[2][2][4][2], const Unit& u, int wr, int wc, int fr, int fq) const {
        const int row0 = u.pm * BM + wr * 64 + fr, col0 = u.pn * HALF + wc * 32 + 8 * fq;
#pragma unroll
        for (int ai = 0; ai < 2; ++ai)
#pragma unroll
            for (int m = 0; m < 4; ++m) { bf16_t* rowp = O + (size_t)(row0 + ai * HALF + m * 16) * ldc + col0;
                const f32x4 g0 = acc[ai][0][m][0], g1 = acc[ai][0][m][1], u0 = acc[ai][1][m][0], u1 = acc[ai][1][m][1];
                u32x4 w; w.x = cvt_pk_bf16(silu_f(g0[0]) * u0[0], silu_f(g0[1]) * u0[1]); w.y = cvt_pk_bf16(silu_f(g0[2]) * u0[2], silu_f(g0[3]) * u0[3]);
                w.z = cvt_pk_bf16(silu_f(g1[0]) * u1[0], silu_f(g1[1]) * u1[1]); w.w = cvt_pk_bf16(silu_f(g1[2]) * u1[2], silu_f(g1[3]) * u1[3]);
                *(u32x4*)rowp = w; }
    }
};
struct EpiProj {
    static constexpr bool PERM = true, AFTER_DRAIN = false;
    bf16_t *GQ, *GK, *GV, *GG, *SQ, *SK, *SV; float* GA; const float* rope;
    __device__ __forceinline__ void operator()(const f32x4 (&acc)[2][2][4][2], const Unit& u, int wr, int wc, int fr, int fq) const {
        const int pn = u.pn, row0 = u.pm * BM + wr * 64 + fr;
        if (pn < 6) {
            bf16_t* base; int ld, coff;
            if (pn == 0) { base = GQ; ld = 256; coff = 0; } else if (pn == 1) { base = GK; ld = 256; coff = 0; }
            else if (pn < 4) { base = GV; ld = 512; coff = (pn - 2) * 256; } else { base = GG; ld = 512; coff = (pn - 4) * 256; }
            const bool act = pn >= 4;
#pragma unroll
            for (int ai = 0; ai < 2; ++ai)
#pragma unroll
                for (int m = 0; m < 4; ++m) { bf16_t* rowp = base + (size_t)(row0 + ai * HALF + m * 16) * ld + coff + wc * 32 + 8 * fq;
#pragma unroll
                    for (int bj = 0; bj < 2; ++bj) { f32x4 v0 = acc[ai][bj][m][0], v1 = acc[ai][bj][m][1];
                        if (act) { v0 = (f32x4){silu_f(v0[0]), silu_f(v0[1]), silu_f(v0[2]), silu_f(v0[3])}; v1 = (f32x4){silu_f(v1[0]), silu_f(v1[1]), silu_f(v1[2]), silu_f(v1[3])}; }
                        u32x4 w; w.x = cvt_pk_bf16(v0[0], v0[1]); w.y = cvt_pk_bf16(v0[2], v0[3]); w.z = cvt_pk_bf16(v1[0], v1[1]); w.w = cvt_pk_bf16(v1[2], v1[3]);
                        *(u32x4*)(rowp + bj * HALF) = w; } }
        } else if (pn < 9) {
            bf16_t* base; int ld, coff; float sc = 1.f; bool do_rope = true;
            if (pn < 8) { base = SQ; ld = 512; coff = (4 * (pn - 6) + wc) * 64; sc = 0.125f; }
            else if (wc < 2) { base = SK; ld = 128; coff = wc * 64; }
            else { base = SV; ld = 128; coff = (wc - 2) * 64; do_rope = false; }
#pragma unroll
            for (int ai = 0; ai < 2; ++ai)
#pragma unroll
                for (int m = 0; m < 4; ++m) { const int row = row0 + ai * HALF + m * 16; const int pos = row < 16384 ? (row & 8191) + 16 : row - 16384;
                    const float* rp = rope + (size_t)pos * 64 + 8 * fq;
                    f32x4 o1[2], o2[2];
#pragma unroll
                    for (int n = 0; n < 2; ++n) { const f32x4 x1 = acc[ai][0][m][n], x2 = acc[ai][1][m][n];
                        if (do_rope) { const f32x4 c = *(const f32x4*)(rp + 4 * n), s = *(const f32x4*)(rp + 32 + 4 * n); o1[n] = (x1 * c - x2 * s) * sc; o2[n] = (x2 * c + x1 * s) * sc; }
                        else { o1[n] = x1; o2[n] = x2; } }
                    bf16_t* rowp = base + (size_t)row * ld + coff + 8 * fq;
                    u32x4 w; w.x = cvt_pk_bf16(o1[0][0], o1[0][1]); w.y = cvt_pk_bf16(o1[0][2], o1[0][3]); w.z = cvt_pk_bf16(o1[1][0], o1[1][1]); w.w = cvt_pk_bf16(o1[1][2], o1[1][3]);
                    *(u32x4*)rowp = w;
                    w.x = cvt_pk_bf16(o2[0][0], o2[0][1]); w.y = cvt_pk_bf16(o2[0][2], o2[0][3]); w.z = cvt_pk_bf16(o2[1][0], o2[1][1]); w.w = cvt_pk_bf16(o2[1][2], o2[1][3]);
                    *(u32x4*)(rowp + 32) = w; }
        } else {
            if (wc == 0 && fq < 2) {
#pragma unroll
                for (int ai = 0; ai < 2; ++ai)
#pragma unroll
                    for (int m = 0; m < 4; ++m) { float* rowp = GA + (size_t)(row0 + ai * HALF + m * 16) * 16 + 8 * fq;
                        *(f32x4*)rowp = acc[ai][0][m][0]; *(f32x4*)(rowp + 4) = acc[ai][0][m][1]; }
            }
        }
    }
};

template <class Epi, class Sched, bool ALIGN_EPI = false, bool SP2 = false>
__device__ __forceinline__ void gemm_phase(PG8_LAS unsigned char* lds, const Gemm g, const Sched& S, const Epi& E) {
    int tid_ = threadIdx.x; asm volatile("" : "+v"(tid_));
    const int tid = tid_, wid = __builtin_amdgcn_readfirstlane(tid >> 6), lane = tid & 63, wr = wid >> 2, wc = wid & 3, fr = lane & 15, fq = lane >> 4;
    const int K = g.K, nt = K / BK;
    unsigned voffA[2], voffB[2];
#pragma unroll
    for (int i = 0; i < 2; ++i) { int R, C; stage_rc(tid * 16 + i * 8192, R, C); const int Rb = Epi::PERM ? ((R & ~31) + perm32(R & 31)) : R;
        voffA[i] = (unsigned)(R * K + C) * 2u; voffB[i] = (unsigned)(Rb * K + C) * 2u; }
    const size_t kstep = (size_t)(BK * 2);
    const size_t hstep = (size_t)HALF * K * 2;
    const size_t tstep = 2 * hstep;
    const unsigned ldsw = (unsigned)wid * 1024u;
    const int aoff = lds_byte(wr * 64 + fr, fq * 8), boff = lds_byte(wc * 32 + fr, fq * 8);
#define PG8_SA(b, h) (((b) * 2 + (h)) * HTB)
#define PG8_SB(b, h) ((4 + (b) * 2 + (h)) * HTB)
#define PG8_STAGE(bufoff, gbase, voff) do { _Pragma("unroll") for (int _i = 0; _i < 2; ++_i) \
        __builtin_amdgcn_global_load_lds((const unsigned*)((const char*)(gbase) + (voff)[_i]), (PG8_LAS unsigned*)(lds + (bufoff) + ldsw + _i * 8192), 16, 0, 0); } while (0)
#define PG8_LDA(dst, b, h) do { _Pragma("unroll") for (int m = 0; m < 4; ++m) _Pragma("unroll") for (int k = 0; k < 2; ++k) dst[m][k] = *(const PG8_LAS bf16x8*)(lds + PG8_SA(b, h) + aoff + m * 2048 + k * 1024); } while (0)
#define PG8_LDB(dst, b, h) do { _Pragma("unroll") for (int n = 0; n < 2; ++n) _Pragma("unroll") for (int k = 0; k < 2; ++k) dst[n][k] = *(const PG8_LAS bf16x8*)(lds + PG8_SB(b, h) + boff + n * 2048 + k * 1024); } while (0)
#define PG8_MMA(ai, bj, At, Bt) do { __builtin_amdgcn_s_setprio(1); _Pragma("unroll") for (int m = 0; m < 4; ++m) _Pragma("unroll") for (int n = 0; n < 2; ++n) _Pragma("unroll") for (int k = 0; k < 2; ++k) \
        acc[ai][bj][m][n] = __builtin_amdgcn_mfma_f32_16x16x32_bf16(Bt[n][k], At[m][k], acc[ai][bj][m][n], 0, 0, 0); __builtin_amdgcn_s_setprio(0); } while (0)
#define PG8_WAIT_V(n) asm volatile("s_waitcnt vmcnt(" #n ")" ::: "memory")
#define PG8_WAIT_L(n) asm volatile("s_waitcnt lgkmcnt(" #n ")" ::: "memory")
#define PG8_BAR __builtin_amdgcn_s_barrier()
#define PG8_SCHED __builtin_amdgcn_sched_barrier(0)
    Unit cur, nxt; int ui = 0;
    if (!S.next(0, cur)) return;
    f32x4 acc[2][2][4][2];
#pragma unroll
    for (int a = 0; a < 2; ++a)
#pragma unroll
        for (int b = 0; b < 2; ++b)
#pragma unroll
            for (int m = 0; m < 4; ++m)
#pragma unroll
                for (int n = 0; n < 2; ++n) acc[a][b][m][n] = (f32x4){0.f, 0.f, 0.f, 0.f};
    bf16x8 At[4][2], B0[2][2], B1[2][2];
    const char* cA = (const char*)g.A + (size_t)cur.pm * tstep; const char* cB = (const char*)g.Bt + (size_t)cur.pn * tstep;
    S.a_ready(cur);
    if constexpr (SP2) {
        PG8_STAGE(PG8_SB(0, 0), cB, voffB); PG8_STAGE(PG8_SB(0, 1), cB + hstep, voffB); PG8_STAGE(PG8_SA(0, 0), cA, voffA); PG8_STAGE(PG8_SA(0, 1), cA + hstep, voffA);
        if (wr == 1) PG8_BAR;
        PG8_WAIT_V(2); PG8_BAR;
        PG8_STAGE(PG8_SB(1, 0), cB + kstep, voffB); PG8_STAGE(PG8_SA(1, 0), cA + kstep, voffA); PG8_STAGE(PG8_SB(1, 1), cB + hstep + kstep, voffB);
        PG8_WAIT_V(6); PG8_BAR;
    } else {
        PG8_STAGE(PG8_SB(0, 0), cB, voffB); PG8_STAGE(PG8_SA(0, 0), cA, voffA); PG8_STAGE(PG8_SB(0, 1), cB + hstep, voffB); PG8_STAGE(PG8_SA(0, 1), cA + hstep, voffA);
        if (wr == 1) PG8_BAR;
        PG8_WAIT_V(4); PG8_BAR;
        PG8_STAGE(PG8_SB(1, 0), cB + kstep, voffB); PG8_STAGE(PG8_SA(1, 0), cA + kstep, voffA); PG8_STAGE(PG8_SB(1, 1), cB + hstep + kstep, voffB);
        PG8_WAIT_V(6); PG8_BAR;
    }
    for (;;) {
        const bool has_next = S.next(ui + 1, nxt);
        const char* nA = has_next ? (const char*)g.A + (size_t)nxt.pm * tstep : cA; const char* nB = has_next ? (const char*)g.Bt + (size_t)nxt.pn * tstep : cB;
        for (int t = 0; t < nt; t += 2) {
            const bool last = (t == nt - 2);
            const char* a1 = cA + (size_t)(t + 1) * kstep;
            const char* a2 = last ? nA : cA + (size_t)(t + 2) * kstep; const char* b2 = last ? nB : cB + (size_t)(t + 2) * kstep;
            const char* a3 = a2 + kstep; const char* b3 = b2 + kstep;
            if (last && has_next) S.a_ready(nxt);
            if constexpr (SP2) {
            PG8_LDB(B0, 0, 0); PG8_LDB(B1, 0, 1); PG8_SCHED; PG8_LDA(At, 0, 0); PG8_STAGE(PG8_SA(1, 1), a1 + hstep, voffA);
            PG8_WAIT_V(8); PG8_WAIT_L(0); PG8_BAR; PG8_MMA(0, 0, At, B0); PG8_MMA(0, 1, At, B1); PG8_BAR; PG8_SCHED;
            PG8_LDA(At, 0, 1); PG8_STAGE(PG8_SB(0, 0), b2, voffB); PG8_STAGE(PG8_SB(0, 1), b2 + hstep, voffB); PG8_STAGE(PG8_SA(0, 0), a2, voffA);
            PG8_WAIT_V(8); PG8_WAIT_L(0); PG8_BAR; PG8_MMA(1, 0, At, B0); PG8_MMA(1, 1, At, B1); PG8_BAR; PG8_SCHED;
            PG8_LDB(B0, 1, 0); PG8_LDB(B1, 1, 1); PG8_SCHED; PG8_LDA(At, 1, 0); PG8_STAGE(PG8_SA(0, 1), a2 + hstep, voffA);
            PG8_WAIT_V(8); PG8_WAIT_L(0); PG8_BAR; PG8_MMA(0, 0, At, B0); PG8_MMA(0, 1, At, B1); PG8_BAR; PG8_SCHED;
            PG8_LDA(At, 1, 1); PG8_STAGE(PG8_SB(1, 0), b3, voffB); PG8_STAGE(PG8_SB(1, 1), b3 + hstep, voffB); PG8_STAGE(PG8_SA(1, 0), a3, voffA);
            PG8_WAIT_V(8); PG8_WAIT_L(0); PG8_BAR; PG8_MMA(1, 0, At, B0); PG8_MMA(1, 1, At, B1); PG8_BAR; PG8_SCHED;
            } else {
            PG8_LDB(B0, 0, 0); PG8_SCHED; PG8_LDA(At, 0, 0); PG8_STAGE(PG8_SA(1, 1), a1 + hstep, voffA);
            PG8_WAIT_L(8); PG8_BAR; PG8_WAIT_L(0); PG8_MMA(0, 0, At, B0); PG8_BAR; PG8_SCHED;
            PG8_LDB(B1, 0, 1); PG8_STAGE(PG8_SB(0, 0), b2, voffB);
            PG8_BAR; PG8_WAIT_L(0); PG8_MMA(0, 1, At, B1); PG8_BAR;
            PG8_LDA(At, 0, 1); PG8_STAGE(PG8_SA(0, 0), a2, voffA);
            PG8_BAR; PG8_WAIT_L(0); PG8_MMA(1, 0, At, B0); PG8_BAR; PG8_SCHED;
            PG8_STAGE(PG8_SB(0, 1), b2 + hstep, voffB);
            PG8_WAIT_V(6); PG8_BAR; PG8_MMA(1, 1, At, B1); PG8_BAR;
            PG8_LDB(B0, 1, 0); PG8_SCHED; PG8_LDA(At, 1, 0); PG8_STAGE(PG8_SA(0, 1), a2 + hstep, voffA);
            PG8_WAIT_L(8); PG8_BAR; PG8_WAIT_L(0); PG8_MMA(0, 0, At, B0); PG8_BAR; PG8_SCHED;
            PG8_LDB(B1, 1, 1); PG8_STAGE(PG8_SB(1, 0), b3, voffB);
            PG8_BAR; PG8_WAIT_L(0); PG8_MMA(0, 1, At, B1); PG8_BAR;
            PG8_LDA(At, 1, 1); PG8_STAGE(PG8_SA(1, 0), a3, voffA);
            PG8_BAR; PG8_WAIT_L(0); PG8_MMA(1, 0, At, B0); PG8_BAR; PG8_SCHED;
            PG8_STAGE(PG8_SB(1, 1), b3 + hstep, voffB);
            PG8_WAIT_V(6); PG8_BAR; PG8_MMA(1, 1, At, B1); PG8_BAR;
            }
        }
        if constexpr (ALIGN_EPI) { if (wr == 0) PG8_BAR; }
        if constexpr (!Epi::AFTER_DRAIN) { E(acc, cur, wr, wc, fr, fq); S.done(cur); }
        if (!has_next) break;
#pragma unroll
        for (int a = 0; a < 2; ++a)
#pragma unroll
            for (int b = 0; b < 2; ++b)
#pragma unroll
                for (int m = 0; m < 4; ++m)
#pragma unroll
                    for (int n = 0; n < 2; ++n) acc[a][b][m][n] = (f32x4){0.f, 0.f, 0.f, 0.f};
        cur = nxt; cA = nA; cB = nB; ++ui;
        if constexpr (ALIGN_EPI) { if (wr == 1) PG8_BAR; }
    }
    PG8_WAIT_V(0);
    if constexpr (!ALIGN_EPI) { if (wr == 0) PG8_BAR; }
    PG8_BAR;
    if constexpr (Epi::AFTER_DRAIN) { E.fused(acc, cur, wr, wc, fr, fq, lds, wid, lane); S.done(cur); }
#undef PG8_SA
#undef PG8_SB
#undef PG8_STAGE
#undef PG8_LDA
#undef PG8_LDB
#undef PG8_MMA
#undef PG8_WAIT_V
#undef PG8_WAIT_L
#undef PG8_BAR
#undef PG8_SCHED
}
}

namespace cg = cooperative_groups;
typedef unsigned short bf16;
typedef float f32x4 __attribute__((ext_vector_type(4)));
typedef short bf16x8 __attribute__((ext_vector_type(8)));
typedef short s16x4 __attribute__((ext_vector_type(4)));
typedef unsigned u32x2 __attribute__((ext_vector_type(2)));
typedef unsigned u32x4 __attribute__((ext_vector_type(4)));

constexpr int D = 1024, FF = 2816, SEQ = 8192, NX = 16384, NMETA = 16, NR = NX + NMETA, NRP = 16640;
constexpr int NGU = 2 * FF, NPROJ = 2560;
constexpr float EPS = 1e-6f;
constexpr int NTHREADS = 512, NWAVES = 8;
constexpr int LDS_BYTES = 147456;

constexpr size_t SZ_WGU = (size_t)NGU * D * 2, SZ_WD = (size_t)D * FF * 2, SZ_WIN = (size_t)NPROJ * D * 2, SZ_WOUT = (size_t)D * D * 2;
constexpr size_t WS_WGU1 = 0, WS_WD1 = WS_WGU1 + SZ_WGU, WS_WIN = WS_WD1 + SZ_WD, WS_WOUT = WS_WIN + SZ_WIN, WS_WGU2 = WS_WOUT + SZ_WOUT, WS_WD2 = WS_WGU2 + SZ_WGU;
constexpr size_t WS_ROPE = WS_WD2 + SZ_WD, SZ_ROPE = (size_t)(SEQ + NMETA) * 64 * 4;
constexpr size_t WS_DL = WS_ROPE + SZ_ROPE, SZ_DL = (size_t)8 * 128 * 64 * 4;
constexpr size_t WS_A = WS_DL + SZ_DL, SZ_A = (size_t)NRP * D * 2;
constexpr size_t WS_F = WS_A + SZ_A, SZ_F = SZ_A;
constexpr size_t WS_ST = WS_F + SZ_F, SZ_ST = (size_t)8 * 128 * 8192 * 2;
constexpr size_t WS_ACT = WS_ST + SZ_ST, SZ_ACT = (size_t)NRP * FF * 2;
constexpr size_t WS_CTL = WS_ACT + SZ_ACT, SZ_CTL = 16384;
constexpr size_t WS_GVT = WS_CTL + SZ_CTL, SZ_GVT = (size_t)8 * 128 * 8192 * 2;
constexpr size_t WS_END = WS_GVT + SZ_GVT;
static_assert(WS_END <= (size_t)256 * 1024 * 1024, "ws map");
static_assert((size_t)8 * 128 * 8192 * 4 <= SZ_F, "UT fits in F");
constexpr size_t PO_GQ = 0, PO_GK = PO_GQ + (size_t)NRP * 256 * 2, PO_GV = PO_GK + (size_t)NRP * 256 * 2, PO_GG = PO_GV + (size_t)NRP * 512 * 2,
                 PO_SQ = PO_GG + (size_t)NRP * 512 * 2, PO_SK = PO_SQ + (size_t)NRP * 512 * 2, PO_SV = PO_SK + (size_t)NRP * 128 * 2, PO_GA = PO_SV + (size_t)NRP * 128 * 2,
                 PO_END = PO_GA + (size_t)NRP * 16 * 4;
static_assert(PO_END <= SZ_ACT, "projection outputs fit in ACT");

struct Params {
    const float *x, *meta, *n1pre, *wg1, *wu1, *wd1, *n1post, *nmixpre, *win, *wa2, *ba, *glanorm, *sinks, *swanorm, *wout, *nmixpost, *n2pre, *wg2, *wu2, *wd2, *n2post;
    float* out; unsigned char* ws;
};

__device__ __forceinline__ unsigned f2bf(float f) { unsigned u = __builtin_bit_cast(unsigned, f); return (u + 0x7fffu + ((u >> 16) & 1u)) >> 16; }
__device__ __forceinline__ unsigned pk2(float lo, float hi) { return f2bf(lo) | (f2bf(hi) << 16); }
__device__ __forceinline__ float bf2f(unsigned short b) { return __builtin_bit_cast(float, (unsigned)b << 16); }
__device__ __forceinline__ float wave_sum(float v) {
#pragma unroll
    for (int o = 1; o < 64; o <<= 1) v += __shfl_xor(v, o);
    return v;
}
__device__ __forceinline__ float fexp(float x) { return __builtin_amdgcn_exp2f(x * 1.4426950408889634f); }
__device__ __forceinline__ float flog(float x) { return __builtin_amdgcn_logf(x) * 0.6931471805599453f; }
__device__ __forceinline__ f32x4 mma16(bf16x8 first, bf16x8 second, f32x4 c) { return __builtin_amdgcn_mfma_f32_16x16x32_bf16(first, second, c, 0, 0, 0); }

__device__ __forceinline__ void transpose_item(const float* W, int Nsrc, int K, int srccol, int nvalid, bf16* WT, int destrow0, int kb, float* scr, int lane) {
    const int k0 = 64 * kb, c = lane & 31;
#pragma unroll 8
    for (int i = 0; i < 32; ++i) { const int kk = 2 * i + (lane >> 5); scr[kk * 33 + c] = (c < nvalid) ? W[(size_t)(k0 + kk) * Nsrc + srccol + c] : 0.f; }
    asm volatile("s_waitcnt lgkmcnt(0)" ::: "memory");
    const int c8 = lane & 7;
#pragma unroll
    for (int j = 0; j < 4; ++j) { const int n = (lane >> 3) + 8 * j; const float* s = scr + (8 * c8) * 33 + n;
        u32x4 o; o.x = pk2(s[0 * 33], s[1 * 33]); o.y = pk2(s[2 * 33], s[3 * 33]); o.z = pk2(s[4 * 33], s[5 * 33]); o.w = pk2(s[6 * 33], s[7 * 33]);
        *(u32x4*)(WT + (size_t)(destrow0 + n) * K + k0 + 8 * c8) = o; }
    asm volatile("s_waitcnt lgkmcnt(0)" ::: "memory");
}
__device__ __forceinline__ void rms_row_to_bf16(const float* xrow, const float* w, bf16* orow, int lane) {
    f32x4 v[4]; float s = 0.f;
#pragma unroll
    for (int j = 0; j < 4; ++j) { v[j] = *(const f32x4*)(xrow + 4 * lane + 256 * j); s += (v[j].x * v[j].x + v[j].y * v[j].y) + (v[j].z * v[j].z + v[j].w * v[j].w); }
    const float r = 1.f / sqrtf(wave_sum(s) * (1.f / D) + EPS);
#pragma unroll
    for (int j = 0; j < 4; ++j) { const f32x4 ww = *(const f32x4*)(w + 4 * lane + 256 * j); const f32x4 o = v[j] * r * ww;
        u32x2 p; p.x = pk2(o.x, o.y); p.y = pk2(o.z, o.w); *(u32x2*)(orow + 4 * lane + 256 * j) = p; }
}
__device__ __forceinline__ void p0_prologue(const Params& P, unsigned char* sm, int gw, int NGW, int wave, int lane) {
    unsigned char* ws = P.ws;
    float* scr = (float*)(sm + wave * 16384);
    constexpr int I_GU = 16 * 176, I_D = 44 * 32, I_IN = 16 * 80, I_OUT = 16 * 32;
    constexpr int NITEMS = 2 * I_GU + 2 * I_D + I_IN + I_OUT;
    for (int it = gw; it < NITEMS; it += NGW) {
        int r = it;
        if (r < 2 * I_GU) {
            const int which = r / I_GU; r -= which * I_GU; const int kb = r / 176, gi = r % 176, pn = gi >> 3, sub = gi & 7;
            const float* W = which == 0 ? ((sub >> 2) ? P.wu1 : P.wg1) : ((sub >> 2) ? P.wu2 : P.wg2);
            transpose_item(W, FF, D, 128 * pn + 32 * (sub & 3), 32, (bf16*)(ws + (which == 0 ? WS_WGU1 : WS_WGU2)), 32 * gi, kb, scr, lane); continue; }
        r -= 2 * I_GU;
        if (r < 2 * I_D) { const int which = r / I_D; r -= which * I_D; const int kb = r / 32, gi = r % 32;
            transpose_item(which == 0 ? P.wd1 : P.wd2, D, FF, 32 * gi, 32, (bf16*)(ws + (which == 0 ? WS_WD1 : WS_WD2)), 32 * gi, kb, scr, lane); continue; }
        r -= 2 * I_D;
        if (r < I_IN) { const int kb = r / 80, gi = r % 80, pn = gi >> 3, sub = gi & 7, bj = sub >> 2, wc = sub & 3; int src, nv = 32;
            if (pn < 6) src = 256 * pn + 32 * sub;
            else if (pn < 8) src = 1552 + (4 * (pn - 6) + wc) * 64 + 32 * bj;
            else if (pn == 8) src = (wc < 2) ? 2064 + wc * 64 + 32 * bj : 2192 + (wc - 2) * 64 + 32 * bj;
            else { src = 1536; nv = (sub == 0) ? 16 : 0; }
            transpose_item(P.win, 2320, D, src, nv, (bf16*)(ws + WS_WIN), 32 * gi, kb, scr, lane); continue; }
        r -= I_IN;
        { const int kb = r / 32, gi = r % 32; transpose_item(P.wout, D, D, 32 * gi, 32, (bf16*)(ws + WS_WOUT), 32 * gi, kb, scr, lane); }
    }
    { float* rope = (float*)(ws + WS_ROPE); const int gt = gw * 64 + lane, NGT = NGW * 64;
      for (int e = gt; e < (SEQ + NMETA) * 32; e += NGT) { const int pos = e >> 5, dd = e & 31;
          const float inv = (float)(1.0 / pow(10000.0, (double)dd / 32.0)); const float ang = (float)pos * inv;
          double sn, cs; sincos((double)ang, &sn, &cs); rope[pos * 64 + dd] = (float)cs; rope[pos * 64 + 32 + dd] = (float)sn; } }
    bf16* A = (bf16*)(ws + WS_A);
    for (int m = gw; m < NRP; m += NGW) {
        if (m < NR) rms_row_to_bf16(m < NX ? P.x + (size_t)m * D : P.meta + (size_t)(m - NX) * D, P.n1pre, A + (size_t)m * D, lane);
        else {
#pragma unroll
            for (int j = 0; j < 4; ++j) *(u32x2*)(A + (size_t)m * D + 4 * lane + 256 * j) = (u32x2){0u, 0u};
        }
    }
}

template <bool HAS_NEXT>
__device__ __forceinline__ void rowpass(const bf16* Fb, const float* hx, const float* meta, int nrows, float scale, const float* wpost, const float* wnext, float* Hdst, bf16* Adst, int gw, int NGW, int lane) {
    for (int row = gw; row < nrows; row += NGW) {
        const float* hrow = row < NX ? hx + (size_t)row * D : meta + (size_t)(row - NX) * D;
        f32x4 h[4], f[4]; float ss = 0.f;
#pragma unroll
        for (int j = 0; j < 4; ++j) { const u32x2 fb = *(const u32x2*)(Fb + (size_t)row * D + 4 * lane + 256 * j);
            f[j] = (f32x4){bf2f((unsigned short)(fb.x & 0xffffu)), bf2f((unsigned short)(fb.x >> 16)), bf2f((unsigned short)(fb.y & 0xffffu)), bf2f((unsigned short)(fb.y >> 16))};
            h[j] = *(const f32x4*)(hrow + 4 * lane + 256 * j);
            ss += (f[j].x * f[j].x + f[j].y * f[j].y) + (f[j].z * f[j].z + f[j].w * f[j].w); }
        const float r = scale / sqrtf(wave_sum(ss) * (1.f / D) + EPS);
        float s2 = 0.f;
#pragma unroll
        for (int j = 0; j < 4; ++j) { const f32x4 w = *(const f32x4*)(wpost + 4 * lane + 256 * j); h[j] = h[j] + f[j] * r * w;
            s2 += (h[j].x * h[j].x + h[j].y * h[j].y) + (h[j].z * h[j].z + h[j].w * h[j].w); }
        if (Hdst && row < NX) {
#pragma unroll
            for (int j = 0; j < 4; ++j) *(f32x4*)(Hdst + (size_t)row * D + 4 * lane + 256 * j) = h[j];
        }
        if (HAS_NEXT) {
            const float r2 = 1.f / sqrtf(wave_sum(s2) * (1.f / D) + EPS);
#pragma unroll
            for (int j = 0; j < 4; ++j) { const f32x4 w = *(const f32x4*)(wnext + 4 * lane + 256 * j); const f32x4 o = h[j] * r2 * w;
                u32x2 p; p.x = pk2(o.x, o.y); p.y = pk2(o.z, o.w); *(u32x2*)(Adst + (size_t)row * D + 4 * lane + 256 * j) = p; }
        }
    }
}

__device__ __forceinline__ void meta_down(const bf16* ACT, const bf16* Wd_t, bf16* F, unsigned char* sm, int wave, int lane) {
    const int g = blockIdx.x; if (g >= 64) return;
    const int fr = lane & 15, fq = lane >> 4;
    f32x4 acc = (f32x4){0.f, 0.f, 0.f, 0.f};
    const bf16* ap = ACT + (size_t)(NX + fr) * FF + wave * 352 + 8 * fq;
    const bf16* bp = Wd_t + (size_t)(16 * g + fr) * FF + wave * 352 + 8 * fq;
#pragma unroll
    for (int s = 0; s < 11; ++s) { const bf16x8 a = *(const bf16x8*)(ap + 32 * s), b = *(const bf16x8*)(bp + 32 * s); acc = mma16(b, a, acc); }
    f32x4* red = (f32x4*)sm;
    red[wave * 64 + lane] = acc;
    __syncthreads();
    if (wave == 0) { f32x4 t = red[lane];
#pragma unroll
        for (int w = 1; w < 8; ++w) t = t + red[w * 64 + lane];
        u32x2 p; p.x = pk2(t.x, t.y); p.y = pk2(t.z, t.w); *(u32x2*)(F + (size_t)(NX + fr) * D + 16 * g + 4 * fq) = p; }
    __syncthreads();
}

__device__ __forceinline__ int gla_row(int b, int c, int t) { return c == 0 ? (t < 48 ? -1 : NX + t - 48) : b * SEQ + (c - 1) * 64 + t; }
constexpr int GLA_KT = 0, GLA_VT = 9216, GLA_BUF = 27648;
constexpr int GLC_PS = 0, GLC_SS = 9216;
__device__ __forceinline__ void gla_phase_a(const Params& P, unsigned char* sm, int tid, int wave, int lane) {
    unsigned char* ws = P.ws;
    bf16* GQ = (bf16*)(ws + WS_ACT + PO_GQ); bf16* GK = (bf16*)(ws + WS_ACT + PO_GK); const bf16* GV = (const bf16*)(ws + WS_ACT + PO_GV); const float* GA = (const float*)(ws + WS_ACT + PO_GA);
    float* UT = (float*)(ws + WS_F); float* DL = (float*)(ws + WS_DL); bf16* GVT = (bf16*)(ws + WS_GVT);
    const int fr = lane & 15, fq = lane >> 4, t = lane;
    int buf = 0;
    for (int pidx = blockIdx.x; pidx < 1032; pidx += gridDim.x) {
        const int bh = pidx / 129, c = pidx - bh * 129, b = bh >> 2, h = bh & 3;
        { buf ^= 1;
            bf16* KT = (bf16*)(sm + buf * GLA_BUF + GLA_KT); bf16* VT = (bf16*)(sm + buf * GLA_BUF + GLA_VT);
            const int row = gla_row(b, c, t);
            f32x4 g4[4];
#pragma unroll
            for (int i = 0; i < 4; ++i) g4[i] = row >= 0 ? *(const f32x4*)(GA + (size_t)row * 16 + 4 * i) : (f32x4){0.f, 0.f, 0.f, 0.f};
            float z[8];
            { const f32x4 b0 = *(const f32x4*)(P.ba + h * 64 + 8 * wave), b1 = *(const f32x4*)(P.ba + h * 64 + 8 * wave + 4);
              z[0] = b0.x; z[1] = b0.y; z[2] = b0.z; z[3] = b0.w; z[4] = b1.x; z[5] = b1.y; z[6] = b1.z; z[7] = b1.w; }
#pragma unroll
            for (int r = 0; r < 16; ++r) { const float* wa = P.wa2 + r * 256 + h * 64 + 8 * wave; const f32x4 w0 = *(const f32x4*)wa, w1 = *(const f32x4*)(wa + 4); const float g = g4[r >> 2][r & 3];
                z[0] += g * w0.x; z[1] += g * w0.y; z[2] += g * w0.z; z[3] += g * w0.w; z[4] += g * w1.x; z[5] += g * w1.y; z[6] += g * w1.z; z[7] += g * w1.w; }
            float bc[8], bl[8];
#pragma unroll
            for (int dd = 0; dd < 8; ++dd) { float la = (row >= 0) ? -(fmaxf(-z[dd], 0.f) + flog(1.f + fexp(-fabsf(z[dd])))) * (1.f / 16.f) : 0.f;
#pragma unroll
                for (int o = 1; o < 64; o <<= 1) { const float y = __shfl_up(la, o); if (lane >= o) la += y; }
                bc[dd] = la; bl[dd] = __shfl(la, 63); }
            float k[8];
            { u32x4 kr = (u32x4){0u, 0u, 0u, 0u}; if (row >= 0) kr = *(const u32x4*)(GK + (size_t)row * 256 + h * 64 + 8 * wave);
              k[0] = bf2f((unsigned short)(kr.x & 0xffffu)); k[1] = bf2f((unsigned short)(kr.x >> 16)); k[2] = bf2f((unsigned short)(kr.y & 0xffffu)); k[3] = bf2f((unsigned short)(kr.y >> 16));
              k[4] = bf2f((unsigned short)(kr.z & 0xffffu)); k[5] = bf2f((unsigned short)(kr.z >> 16)); k[6] = bf2f((unsigned short)(kr.w & 0xffffu)); k[7] = bf2f((unsigned short)(kr.w >> 16)); }
            if (c <= 127) {
#pragma unroll
                for (int dd = 0; dd < 8; ++dd) KT[(8 * wave + dd) * 72 + t] = (bf16)f2bf(k[dd] * fexp(bl[dd] - bc[dd]));
                if (lane == 63) {
#pragma unroll
                    for (int dd = 0; dd < 8; ++dd) DL[(bh * 128 + c) * 64 + 8 * wave + dd] = fexp(bc[dd]);
                }
            }
            if (c >= 1) {
                const u32x4 qr = *(const u32x4*)(GQ + (size_t)row * 256 + h * 64 + 8 * wave);
                float q[8];
                q[0] = bf2f((unsigned short)(qr.x & 0xffffu)); q[1] = bf2f((unsigned short)(qr.x >> 16)); q[2] = bf2f((unsigned short)(qr.y & 0xffffu)); q[3] = bf2f((unsigned short)(qr.y >> 16));
                q[4] = bf2f((unsigned short)(qr.z & 0xffffu)); q[5] = bf2f((unsigned short)(qr.z >> 16)); q[6] = bf2f((unsigned short)(qr.w & 0xffffu)); q[7] = bf2f((unsigned short)(qr.w >> 16));
                float e[8];
#pragma unroll
                for (int dd = 0; dd < 8; ++dd) { e[dd] = fexp(bc[dd]); q[dd] = q[dd] * e[dd] * 0.125f; k[dd] = k[dd] * __builtin_amdgcn_rcpf(e[dd]); }
                u32x4 qo, ko; qo.x = pk2(q[0], q[1]); qo.y = pk2(q[2], q[3]); qo.z = pk2(q[4], q[5]); qo.w = pk2(q[6], q[7]);
                ko.x = pk2(k[0], k[1]); ko.y = pk2(k[2], k[3]); ko.z = pk2(k[4], k[5]); ko.w = pk2(k[6], k[7]);
                *(u32x4*)(GQ + (size_t)row * 256 + h * 64 + 8 * wave) = qo; *(u32x4*)(GK + (size_t)row * 256 + h * 64 + 8 * wave) = ko;
            }
            { u32x4 v0 = (u32x4){0u, 0u, 0u, 0u}, v1 = v0;
              if (row >= 0) { v0 = *(const u32x4*)(GV + (size_t)row * 512 + h * 128 + 16 * wave); v1 = *(const u32x4*)(GV + (size_t)row * 512 + h * 128 + 16 * wave + 8); }
              bf16* vp = VT + (16 * wave) * 72 + t;
              vp[0 * 72] = (bf16)(v0.x & 0xffffu); vp[1 * 72] = (bf16)(v0.x >> 16); vp[2 * 72] = (bf16)(v0.y & 0xffffu); vp[3 * 72] = (bf16)(v0.y >> 16);
              vp[4 * 72] = (bf16)(v0.z & 0xffffu); vp[5 * 72] = (bf16)(v0.z >> 16); vp[6 * 72] = (bf16)(v0.w & 0xffffu); vp[7 * 72] = (bf16)(v0.w >> 16);
              vp[8 * 72] = (bf16)(v1.x & 0xffffu); vp[9 * 72] = (bf16)(v1.x >> 16); vp[10 * 72] = (bf16)(v1.y & 0xffffu); vp[11 * 72] = (bf16)(v1.y >> 16);
              vp[12 * 72] = (bf16)(v1.z & 0xffffu); vp[13 * 72] = (bf16)(v1.z >> 16); vp[14 * 72] = (bf16)(v1.w & 0xffffu); vp[15 * 72] = (bf16)(v1.w >> 16); }
            __syncthreads();
            if (c <= 127) {
                f32x4 acc[4];
#pragma unroll
                for (int dt = 0; dt < 4; ++dt) acc[dt] = (f32x4){0.f, 0.f, 0.f, 0.f};
#pragma unroll
                for (int s = 0; s < 2; ++s) { const bf16x8 vf = *(const bf16x8*)(VT + (16 * wave + fr) * 72 + 32 * s + 8 * fq);
#pragma unroll
                    for (int dt = 0; dt < 4; ++dt) { const bf16x8 kf = *(const bf16x8*)(KT + (16 * dt + fr) * 72 + 32 * s + 8 * fq); acc[dt] = mma16(kf, vf, acc[dt]); } }
                float* up = UT + (size_t)(bh * 128 + c) * 8192 + (16 * wave + fr) * 64 + 4 * fq;
#pragma unroll
                for (int dt = 0; dt < 4; ++dt) *(f32x4*)(up + 16 * dt) = acc[dt];
            }
            if (c >= 1) { const int v = tid >> 2, tq = tid & 3; const bf16* src = VT + v * 72 + 16 * tq; bf16* dst = GVT + (size_t)(bh * 128 + c - 1) * 8192 + v * 64 + 16 * tq;
                *(u32x4*)dst = *(const u32x4*)src; *(u32x4*)(dst + 8) = *(const u32x4*)(src + 8); }
        }
    }
    __syncthreads();
}
__device__ __forceinline__ void gla_phase_b(const Params& P, int tid) {
    unsigned char* ws = P.ws;
    const float* UT = (const float*)(ws + WS_F); const float* DL = (const float*)(ws + WS_DL); bf16* ST = (bf16*)(ws + WS_ST);
    if (tid >= 256) return;
    for (int e = blockIdx.x * 256 + tid; e < 65536; e += gridDim.x * 256) {
        const int bh = e >> 13, idx = e & 8191, d = idx & 63; float S = 0.f;
        for (int c0 = 0; c0 < 128; c0 += 16) { float u[16], dl[16];
#pragma unroll
            for (int k = 0; k < 16; ++k) { u[k] = UT[(size_t)(bh * 128 + c0 + k) * 8192 + idx]; dl[k] = DL[(bh * 128 + c0 + k) * 64 + d]; }
#pragma unroll
            for (int k = 0; k < 16; ++k) { S = dl[k] * S + u[k]; ST[(size_t)(bh * 128 + c0 + k) * 8192 + idx] = (bf16)f2bf(S); } }
    }
}
__device__ __forceinline__ void gla_phase_c(const Params& P, unsigned char* sm, int tid, int wave, int lane) {
    unsigned char* ws = P.ws;
    const bf16* GQ = (const bf16*)(ws + WS_ACT + PO_GQ); const bf16* GK = (const bf16*)(ws + WS_ACT + PO_GK); const bf16* GVT = (const bf16*)(ws + WS_GVT);
    const bf16* GG = (const bf16*)(ws + WS_ACT + PO_GG); const bf16* ST = (const bf16*)(ws + WS_ST); bf16* MIX = (bf16*)(ws + WS_A);
    bf16* PS = (bf16*)(sm + GLC_PS); float* SS = (float*)(sm + GLC_SS);
    const int fr = lane & 15, fq = lane >> 4;
    for (int item = blockIdx.x; item < 1024; item += gridDim.x) {
        const int bh = item >> 7, xc = item & 127, b = bh >> 2, h = bh & 3; const int rowb = b * SEQ + xc * 64;
        const bf16* qb = GQ + (size_t)(rowb + fr) * 256 + h * 64 + 8 * fq; const bf16* kb = GK + (size_t)(rowb + fr) * 256 + h * 64 + 8 * fq;
#pragma unroll
        for (int tt2 = 0; tt2 < 2; ++tt2) { const int tt = wave + 8 * tt2, it = tt >> 2, jt = tt & 3; f32x4 a = (f32x4){0.f, 0.f, 0.f, 0.f};
            if (jt <= it) {
#pragma unroll
                for (int s = 0; s < 2; ++s) { const bf16x8 kf = *(const bf16x8*)(kb + (size_t)(16 * jt) * 256 + 32 * s), qf = *(const bf16x8*)(qb + (size_t)(16 * it) * 256 + 32 * s); a = mma16(kf, qf, a); }
                if (jt == it) {
#pragma unroll
                    for (int e = 0; e < 4; ++e) if (4 * fq + e > fr) a[e] = 0.f;
                }
            }
            u32x2 p; p.x = pk2(a[0], a[1]); p.y = pk2(a[2], a[3]); *(u32x2*)(PS + (16 * it + fr) * 72 + 16 * jt + 4 * fq) = p; }
        const bf16* vtp = GVT + (size_t)item * 8192 + (16 * wave + fr) * 64 + 8 * fq; const bf16* stp = ST + (size_t)item * 8192 + (16 * wave + fr) * 64 + 8 * fq;
        bf16x8 vf[2], sf[2], qf[4][2];
#pragma unroll
        for (int s = 0; s < 2; ++s) { vf[s] = *(const bf16x8*)(vtp + 32 * s); sf[s] = *(const bf16x8*)(stp + 32 * s);
#pragma unroll
            for (int it = 0; it < 4; ++it) qf[it][s] = *(const bf16x8*)(qb + (size_t)(16 * it) * 256 + 32 * s); }
        __syncthreads();
        f32x4 acc[4];
#pragma unroll
        for (int it = 0; it < 4; ++it) acc[it] = (f32x4){0.f, 0.f, 0.f, 0.f};
#pragma unroll
        for (int s = 0; s < 2; ++s)
#pragma unroll
            for (int it = 0; it < 4; ++it) { const bf16x8 pf = *(const bf16x8*)(PS + (16 * it + fr) * 72 + 32 * s + 8 * fq);
                acc[it] = mma16(vf[s], pf, acc[it]); acc[it] = mma16(sf[s], qf[it][s], acc[it]); }
#pragma unroll
        for (int it = 0; it < 4; ++it) { float p = (acc[it][0] * acc[it][0] + acc[it][1] * acc[it][1]) + (acc[it][2] * acc[it][2] + acc[it][3] * acc[it][3]);
            p += __shfl_xor(p, 16); p += __shfl_xor(p, 32); if (fq == 0) SS[wave * 64 + 16 * it + fr] = p; }
        const f32x4 gw4 = *(const f32x4*)(P.glanorm + 16 * wave + 4 * fq);
        u32x2 gb[4];
#pragma unroll
        for (int it = 0; it < 4; ++it) gb[it] = *(const u32x2*)(GG + (size_t)(rowb + 16 * it + fr) * 512 + h * 128 + 16 * wave + 4 * fq);
        __syncthreads();
#pragma unroll
        for (int it = 0; it < 4; ++it) { const int i = 16 * it + fr; float tot = 0.f;
#pragma unroll
            for (int w = 0; w < 8; ++w) tot += SS[w * 64 + i];
            const float r = 1.f / sqrtf(tot * (1.f / 128.f) + EPS);
            const f32x4 gg = (f32x4){bf2f((unsigned short)(gb[it].x & 0xffffu)), bf2f((unsigned short)(gb[it].x >> 16)), bf2f((unsigned short)(gb[it].y & 0xffffu)), bf2f((unsigned short)(gb[it].y >> 16))};
            const f32x4 o = acc[it] * r * gw4 * gg;
            u32x2 p; p.x = pk2(o.x, o.y); p.y = pk2(o.z, o.w); *(u32x2*)(MIX + (size_t)(rowb + i) * D + h * 128 + 16 * wave + 4 * fq) = p; }
    }
    __syncthreads();
}

constexpr int SW_KS = 0, SW_KROW = 72, SW_VT = 2 * 208 * 72 * 2  , SW_VROW = 212, SW_SS = SW_VT + 2 * 64 * 212 * 2  ;
static_assert(SW_SS + 2048 <= 131072, "swa lds");
__device__ __forceinline__ void swa_phase(const Params& P, unsigned char* sm, int tid, int wave, int lane) {
    unsigned char* ws = P.ws;
    const bf16* SQ = (const bf16*)(ws + WS_ACT + PO_SQ); const bf16* SK = (const bf16*)(ws + WS_ACT + PO_SK); const bf16* SV = (const bf16*)(ws + WS_ACT + PO_SV);
    bf16* MIX = (bf16*)(ws + WS_A);
    bf16* Ks = (bf16*)(sm + SW_KS); bf16* VTs = (bf16*)(sm + SW_VT); float* SS = (float*)(sm + SW_SS);
    const int fr = lane & 15, fq = lane >> 4, hq = wave, kvh = wave >> 2;
    const float sink = P.sinks[hq];
    constexpr float LOG2E = 1.4426950408889634f;
    for (int item = blockIdx.x; item < 256; item += gridDim.x) {
        const int b = item >> 7, t0 = (item & 127) * 64, rowb = b * SEQ;
        for (int idx = tid; idx < 208 * 16; idx += NTHREADS) { const int kk = idx >> 4, ch = idx & 15, hd = ch >> 3, c8 = ch & 7;
            int row; if (kk < 192) { const int xk = t0 - 128 + kk; row = xk >= 0 ? rowb + xk : -1; } else row = NX + kk - 192;
            u32x4 kq = (u32x4){0u, 0u, 0u, 0u}, vq = kq;
            if (row >= 0) { kq = *(const u32x4*)(SK + (size_t)row * 128 + hd * 64 + c8 * 8); vq = *(const u32x4*)(SV + (size_t)row * 128 + hd * 64 + c8 * 8); }
            *(u32x4*)(Ks + (hd * 208 + kk) * SW_KROW + c8 * 8) = kq;
            bf16* vp = VTs + (hd * 64 + c8 * 8) * SW_VROW + kk;
            vp[0 * SW_VROW] = (bf16)(vq.x & 0xffffu); vp[1 * SW_VROW] = (bf16)(vq.x >> 16); vp[2 * SW_VROW] = (bf16)(vq.y & 0xffffu); vp[3 * SW_VROW] = (bf16)(vq.y >> 16);
            vp[4 * SW_VROW] = (bf16)(vq.z & 0xffffu); vp[5 * SW_VROW] = (bf16)(vq.z >> 16); vp[6 * SW_VROW] = (bf16)(vq.w & 0xffffu); vp[7 * SW_VROW] = (bf16)(vq.w >> 16); }
        __syncthreads();
        f32x4 o[4][4];
#pragma unroll
        for (int g = 0; g < 4; ++g) {
            const bf16* qp = SQ + (size_t)(rowb + t0 + 16 * g + fr) * 512 + hq * 64 + 8 * fq;
            const bf16x8 q0 = *(const bf16x8*)qp, q1 = *(const bf16x8*)(qp + 32);
            f32x4 s[10];
#pragma unroll
            for (int u = 0; u < 10; ++u) { const int k0 = (u < 9) ? 16 * (g + u) : 192; const bf16* kp = Ks + (kvh * 208 + k0 + fr) * SW_KROW + 8 * fq;
                const bf16x8 kf0 = *(const bf16x8*)kp, kf1 = *(const bf16x8*)(kp + 32);
                s[u] = mma16(kf0, q0, (f32x4){0.f, 0.f, 0.f, 0.f}); s[u] = mma16(kf1, q1, s[u]); }
            float mx = sink;
#pragma unroll
            for (int u = 0; u < 10; ++u)
#pragma unroll
                for (int e = 0; e < 4; ++e) { bool ok = true;
                    if (u == 0) ok = (4 * fq + e) > fr; if (u == 8) ok = (4 * fq + e) <= fr;
                    if (u < 9) ok = ok && (t0 - 128 + 16 * (g + u) + 4 * fq + e >= 0);
                    s[u][e] = ok ? s[u][e] : -1e30f; mx = fmaxf(mx, s[u][e]); }
            mx = fmaxf(mx, __shfl_xor(mx, 16)); mx = fmaxf(mx, __shfl_xor(mx, 32));
            float l = 0.f;
#pragma unroll
            for (int u = 0; u < 10; ++u)
#pragma unroll
                for (int e = 0; e < 4; ++e) { const float p = __builtin_amdgcn_exp2f((s[u][e] - mx) * LOG2E); s[u][e] = p; l += p; }
            l += __shfl_xor(l, 16); l += __shfl_xor(l, 32);
            l += __builtin_amdgcn_exp2f((sink - mx) * LOG2E);
            const float rl = 1.f / l;
#pragma unroll
            for (int dt = 0; dt < 4; ++dt) o[g][dt] = (f32x4){0.f, 0.f, 0.f, 0.f};
#pragma unroll
            for (int st = 0; st < 5; ++st) { const int ka = 16 * (g + 2 * st), kb = (st < 4) ? 16 * (g + 2 * st + 1) : 192;
                bf16x8 pf; { const unsigned p0 = pk2(s[2 * st][0], s[2 * st][1]), p1 = pk2(s[2 * st][2], s[2 * st][3]), p2 = pk2(s[2 * st + 1][0], s[2 * st + 1][1]), p3 = pk2(s[2 * st + 1][2], s[2 * st + 1][3]);
                    pf = __builtin_bit_cast(bf16x8, (u32x4){p0, p1, p2, p3}); }
#pragma unroll
                for (int dt = 0; dt < 4; ++dt) { const bf16* vp = VTs + (kvh * 64 + 16 * dt + fr) * SW_VROW + 4 * fq;
                    const u32x2 va = *(const u32x2*)(vp + ka), vb = *(const u32x2*)(vp + kb);
                    const bf16x8 vf = __builtin_bit_cast(bf16x8, (u32x4){va.x, va.y, vb.x, vb.y});
                    o[g][dt] = mma16(vf, pf, o[g][dt]); } }
            float ssq = 0.f;
#pragma unroll
            for (int dt = 0; dt < 4; ++dt) { o[g][dt] = o[g][dt] * rl; ssq += (o[g][dt][0] * o[g][dt][0] + o[g][dt][1] * o[g][dt][1]) + (o[g][dt][2] * o[g][dt][2] + o[g][dt][3] * o[g][dt][3]); }
            ssq += __shfl_xor(ssq, 16); ssq += __shfl_xor(ssq, 32);
            if (fq == 0) SS[wave * 64 + 16 * g + fr] = ssq;
        }
        __syncthreads();
#pragma unroll
        for (int g = 0; g < 4; ++g) { const int i = 16 * g + fr; float tot = 0.f;
#pragma unroll
            for (int w = 0; w < 8; ++w) tot += SS[w * 64 + i];
            const float r = 1.f / sqrtf(tot * (1.f / 512.f) + EPS);
#pragma unroll
            for (int dt = 0; dt < 4; ++dt) { const f32x4 w4 = *(const f32x4*)(P.swanorm + hq * 64 + 16 * dt + 4 * fq); const f32x4 ov = o[g][dt] * r * w4;
                u32x2 p; p.x = pk2(ov.x, ov.y); p.y = pk2(ov.z, ov.w); *(u32x2*)(MIX + (size_t)(rowb + t0 + i) * D + 512 + hq * 64 + 16 * dt + 4 * fq) = p; } }
        __syncthreads();
    }
}

#define LAS __attribute__((address_space(3)))
#define XB_TMO      128
#define XB_XCNT(j)  (256  + 64 * (j))
#define XB_XSUB(j)  (1280 + 64 * (j))
#define XB_XGEN(j)  (2304 + 64 * (j))
#define XB_TOP      3328
#define XB_TOPGEN   3392
#define XCD_BAR_WORDS 3456
#define XB_SPIN_CAP (1u << 18)

__device__ __forceinline__ unsigned xb_ld(unsigned* p)              { return __hip_atomic_load(p, __ATOMIC_RELAXED, __HIP_MEMORY_SCOPE_AGENT); }
__device__ __forceinline__ unsigned xb_add(unsigned* p, unsigned v) { return __hip_atomic_fetch_add(p, v, __ATOMIC_RELAXED, __HIP_MEMORY_SCOPE_AGENT); }
__device__ __forceinline__ unsigned xb_xcc_id() { return (unsigned)__builtin_amdgcn_s_getreg((3 << 11) | 20) & 0xFu; }
#define XB_SPIN(cond, bar) do { unsigned _sp = 0; while (cond) { __builtin_amdgcn_s_sleep(1); \
    if ((++_sp & 255u) == 0u) { if (xb_ld(&(bar)[XB_TMO])) break; if (_sp > XB_SPIN_CAP) { atomicAdd(&(bar)[XB_TMO], 1u); break; } } } } while (0)

struct XcdBarrier {
    unsigned* bar; unsigned x;
    volatile LAS unsigned* st;
};

__device__ __forceinline__ XcdBarrier xcd_barrier_post(unsigned* bar, volatile LAS unsigned* st) {
    XcdBarrier b; b.bar = bar; b.x = xb_xcc_id(); b.st = st;
    if (threadIdx.x == 0) (void)xb_add(&bar[XB_XCNT(b.x)], 1u);
    return b;
}
__device__ __forceinline__ void xcd_barrier_complete(unsigned* bar, unsigned x, unsigned& nloc, unsigned& nx) {
    const unsigned G = gridDim.x * gridDim.y * gridDim.z;
    unsigned sum, cnt, mine, sp = 0u;
    for (;;) {
        sum = 0u; cnt = 0u; mine = 0u;
#pragma unroll
        for (unsigned j = 0; j < 16; ++j) { const unsigned c = xb_ld(&bar[XB_XCNT(j)]); sum += c; cnt += (c > 0u) ? 1u : 0u; mine = (j == x) ? c : mine; }
        if (sum == G) break;
        __builtin_amdgcn_s_sleep(1);
        if ((++sp & 255u) == 0u) { if (xb_ld(&bar[XB_TMO])) break; if (sp > XB_SPIN_CAP) { atomicAdd(&bar[XB_TMO], 1u); break; } }
    }
    nloc = mine > 0u ? mine : 1u; nx = cnt > 0u ? cnt : 1u;
}

__device__ __forceinline__ void xcd_barrier(const XcdBarrier& b) {
    asm volatile("s_waitcnt vmcnt(0)" ::: "memory");
    __syncthreads();
    if (threadIdx.x == 0) {
        unsigned* bar = b.bar;
        __builtin_amdgcn_s_waitcnt(0);
        unsigned nloc = b.st[0], nx = b.st[1];
        if (nloc == 0u) { xcd_barrier_complete(bar, b.x, nloc, nx); b.st[0] = nloc; b.st[1] = nx; }
        const unsigned old = xb_add(&bar[XB_XSUB(b.x)], 1u);
        const unsigned gen = old / nloc;
        if (old + 1u == (gen + 1u) * nloc) {
            __builtin_amdgcn_fence(__ATOMIC_RELEASE, "agent");
            asm volatile("s_waitcnt vmcnt(0)" ::: "memory");
            const unsigned og = xb_add(&bar[XB_TOP], 1u);
            const unsigned tg = og / nx;
            if (og + 1u == (tg + 1u) * nx) xb_add(&bar[XB_TOPGEN], 1u);
            else XB_SPIN(xb_ld(&bar[XB_TOPGEN]) == tg, bar);
            __builtin_amdgcn_fence(__ATOMIC_ACQUIRE, "agent");
            xb_add(&bar[XB_XGEN(b.x)], 1u);
            asm volatile("s_waitcnt vmcnt(0)" ::: "memory");
        } else {
            XB_SPIN(xb_ld(&bar[XB_XGEN(b.x)]) == gen, bar);
            __builtin_amdgcn_fence(__ATOMIC_ACQUIRE, "agent");
            asm volatile("s_waitcnt vmcnt(0)" ::: "memory");
        }
    }
    __syncthreads();
}
#ifndef REP_P0
#define REP_P0 1
#endif
#ifndef REP_SWA
#define REP_SWA 1
#endif
#ifndef REP_GA
#define REP_GA 1
#endif
#ifndef REP_GB
#define REP_GB 1
#endif
#ifndef REP_GC
#define REP_GC 1
#endif
#ifndef REP_P1
#define REP_P1 1
#endif
#ifndef REP_P3
#define REP_P3 1
#endif
#ifndef EXTRA_SYNC
#define EXTRA_SYNC 0
#endif
__global__ void __launch_bounds__(NTHREADS, 2) hybrid_fwd(Params P) {
    extern __shared__ __attribute__((aligned(16))) unsigned char lds[];
    cg::grid_group grid = cg::this_grid();
    const int tid = threadIdx.x, lane = tid & 63, wave = __builtin_amdgcn_readfirstlane(tid >> 6);
    const int G = gridDim.x, gw = blockIdx.x * NWAVES + wave, NGW = G * NWAVES;
    unsigned char* ws = P.ws;
    PG8_LAS unsigned char* ring = (PG8_LAS unsigned char*)lds;
    bf16* A = (bf16*)(ws + WS_A); bf16* F = (bf16*)(ws + WS_F); bf16* ACT = (bf16*)(ws + WS_ACT);

    if (tid < 2) ((volatile LAS unsigned*)(lds + 131072))[tid] = 0u;
    if (blockIdx.x == 0) for (int i = tid; i < (int)(SZ_CTL / 4); i += NTHREADS) __hip_atomic_store((unsigned*)(ws + WS_CTL) + i, 0u, __ATOMIC_RELAXED, __HIP_MEMORY_SCOPE_AGENT);
    for (int rep = 0; rep < REP_P0; ++rep) { p0_prologue(P, lds, gw, NGW, wave, lane); __syncthreads(); }
    grid.sync();
    (void)xcd_barrier_post((unsigned*)(ws + WS_CTL), (volatile LAS unsigned*)(lds + 131072));
#define GRID_BAR() do { XcdBarrier b_; b_.bar = (unsigned*)(P.ws + WS_CTL); b_.x = xb_xcc_id(); b_.st = (volatile LAS unsigned*)(lds + 131072); xcd_barrier(b_); } while (0)
    for (int rep = 0; rep < EXTRA_SYNC; ++rep) GRID_BAR();
    for (int rep = 0; rep < REP_P1; ++rep)
    { pg8::Gemm g{A, (const bf16*)(ws + WS_WGU1), NRP, NGU, D}; pg8::StaticOrder S; S.init(NRP, NGU, G, (int)blockIdx.x); pg8::EpiSwiglu E{ACT, FF};
      pg8::gemm_phase<pg8::EpiSwiglu, pg8::StaticOrder, true, true>(ring, g, S, E); }
    GRID_BAR();
    { meta_down(ACT, (const bf16*)(ws + WS_WD1), F, lds, wave, lane);
      pg8::Gemm g{ACT, (const bf16*)(ws + WS_WD1), NX, D, FF}; pg8::StaticOrder S; S.init(NX, D, G, (int)blockIdx.x); pg8::EpiPlain E{F, D};
      pg8::gemm_phase<pg8::EpiPlain, pg8::StaticOrder, true, true>(ring, g, S, E); }
    GRID_BAR();
    for (int rep = 0; rep < REP_P3; ++rep) rowpass<true>(F, P.x, P.meta, NR, 0.5f, P.n1post, P.nmixpre, P.out, A, gw, NGW, lane);
    GRID_BAR();
    { pg8::Gemm g{A, (const bf16*)(ws + WS_WIN), NRP, NPROJ, D}; pg8::StaticOrder S; S.init(NRP, NPROJ, G, (int)blockIdx.x);
      unsigned char* po = ws + WS_ACT;
      pg8::EpiProj E{(bf16*)(po + PO_GQ), (bf16*)(po + PO_GK), (bf16*)(po + PO_GV), (bf16*)(po + PO_GG), (bf16*)(po + PO_SQ), (bf16*)(po + PO_SK), (bf16*)(po + PO_SV), (float*)(po + PO_GA), (const float*)(ws + WS_ROPE)};
      pg8::gemm_phase<pg8::EpiProj, pg8::StaticOrder, true, true>(ring, g, S, E); }
    GRID_BAR();
    for (int rep = 0; rep < REP_SWA; ++rep) swa_phase(P, lds, tid, wave, lane);
    gla_phase_a(P, lds, tid, wave, lane);
    GRID_BAR();
    for (int rep = 0; rep < REP_GB; ++rep) gla_phase_b(P, tid);
    GRID_BAR();
    for (int rep = 0; rep < REP_GC; ++rep) gla_phase_c(P, lds, tid, wave, lane);
    GRID_BAR();
    { pg8::Gemm g{A, (const bf16*)(ws + WS_WOUT), NX, D, D}; pg8::StaticOrder S; S.init(NX, D, G, (int)blockIdx.x); pg8::EpiPlain E{F, D};
      pg8::gemm_phase<pg8::EpiPlain, pg8::StaticOrder, true, true>(ring, g, S, E); }
    GRID_BAR();
    rowpass<true>(F, P.out, P.meta, NX, 1.0f, P.nmixpost, P.n2pre, P.out, A, gw, NGW, lane);
    GRID_BAR();
    { pg8::Gemm g{A, (const bf16*)(ws + WS_WGU2), NX, NGU, D}; pg8::StaticOrder S; S.init(NX, NGU, G, (int)blockIdx.x); pg8::EpiSwiglu E{ACT, FF};
      pg8::gemm_phase<pg8::EpiSwiglu, pg8::StaticOrder, true, true>(ring, g, S, E); }
    GRID_BAR();
    { pg8::Gemm g{ACT, (const bf16*)(ws + WS_WD2), NX, D, FF}; pg8::StaticOrder S; S.init(NX, D, G, (int)blockIdx.x); pg8::EpiPlain E{F, D};
      pg8::gemm_phase<pg8::EpiPlain, pg8::StaticOrder, true, true>(ring, g, S, E); }
    GRID_BAR();
    rowpass<false>(F, P.out, P.meta, NX, 0.5f, P.n2post, nullptr, P.out, nullptr, gw, NGW, lane);
}

extern "C" void kernel_launch(void* const* d_in, const int* in_sizes, int n_in, void* d_out, int out_size, void* d_ws, size_t ws_size, hipStream_t stream) {
    static int grid = 0;
    if (grid == 0) {
        if (n_in != 21 || in_sizes[0] != NX * D || out_size != NX * D || ws_size < WS_END) { fprintf(stderr, "kernel_launch: unexpected problem shape (n_in %d, ws %zu)\n", n_in, ws_size); grid = -1; return; }
        int dev = 0, cus = 0, per_cu = 0;
        (void)hipGetDevice(&dev); (void)hipDeviceGetAttribute(&cus, hipDeviceAttributeMultiprocessorCount, dev);
        if (hipFuncSetAttribute((const void*)hybrid_fwd, hipFuncAttributeMaxDynamicSharedMemorySize, LDS_BYTES) != hipSuccess) { fprintf(stderr, "kernel_launch: hipFuncSetAttribute failed\n"); grid = -1; return; }
        if (hipOccupancyMaxActiveBlocksPerMultiprocessor(&per_cu, (const void*)hybrid_fwd, NTHREADS, LDS_BYTES) != hipSuccess || per_cu < 1) { fprintf(stderr, "kernel_launch: occupancy query says %d\n", per_cu); per_cu = 1; }
        (void)hipGetLastError();
        grid = cus;
    }
    if (grid < 0) return;
    Params p{};
    const float** pp = (const float**)&p;
    for (int i = 0; i < 21; ++i) pp[i] = (const float*)d_in[i];
    p.out = (float*)d_out; p.ws = (unsigned char*)d_ws;
    void* args[] = {&p};
    hipError_t e = hipLaunchCooperativeKernel((const void*)hybrid_fwd, dim3(grid), dim3(NTHREADS), args, LDS_BYTES, stream);
    if (e != hipSuccess) fprintf(stderr, "cooperative launch failed: %s (grid %d)\n", hipGetErrorString(e), grid);
}
```
